# Optimizing an MI355X kernel written in HIP

```python
import math
import jax, jax.numpy as jnp
from jax import lax
import numpy as np

D_MODEL = 2048
BATCH = 1
SEQ = 8192
DEPTH = 4
DEC_BATCH = 8
DEC_SEQ = 2048
PAST_LEN = 128

N_EVEN = (DEPTH + 1) // 2
N_ODD = DEPTH // 2
EPS = 1e-6
D_FF = 5632
POOL_WIDTH = D_MODEL // 2
POOL_WINDOWS = (2, 4, 8, 16)
N_POOL_GROUPS = len(POOL_WINDOWS)
POOL_GROUP = POOL_WIDTH // N_POOL_GROUPS
HYENA_WIDTH = D_MODEL - POOL_WIDTH
HYENA_EMB_BANDS = 16
HYENA_EMB_DIM = 1 + 2 * HYENA_EMB_BANDS
HYENA_FILTER_ORDER = 64
HYENA_FAST_DECAY = 0.3
HYENA_SLOW_DECAY = 1.5
HYENA_TARGET = 1e-2
AB_IN = POOL_WIDTH + 3 * HYENA_WIDTH
N_HEADS = 16
N_KV_HEADS = 4
HEAD_DIM = 128
GQA_GROUP = N_HEADS // N_KV_HEADS
WINDOW = 128
BLOCK = 128
QKV_OUT = (N_HEADS + 2 * N_KV_HEADS) * HEAD_DIM
N_BUCKETS = 32
MAX_DISTANCE = 128

kernel_name = "hybrid_pool_hyena_swa_encoder"


def rmsnorm(x, g):
    xf = x.astype(jnp.float32)
    y = xf * lax.rsqrt(jnp.mean(xf * xf, axis=-1, keepdims=True) + EPS)
    return (y * g.astype(jnp.float32)).astype(x.dtype)


def swiglu(h, w_in, w_out):
    gate, up = jnp.split(h @ w_in, 2, axis=-1)
    return (jax.nn.silu(gate) * up) @ w_out


def multiscale_pool(u, w_grp, scale):
    B, L, _ = u.shape
    uf = u.astype(jnp.float32)
    cs = jnp.concatenate([jnp.zeros((B, 1, POOL_WIDTH), jnp.float32), jnp.cumsum(uf, axis=1)], axis=1)
    t = jnp.arange(L)
    outs = []
    for g, w in enumerate(POOL_WINDOWS):
        sl = slice(g * POOL_GROUP, (g + 1) * POOL_GROUP)
        lo = jnp.clip(t - w // 2, 0, L)
        hi = jnp.clip(t + w // 2, 0, L)
        csg = cs[..., sl]
        s = jnp.take(csg, hi, axis=1) - jnp.take(csg, lo, axis=1)
        mean = s / (hi - lo).astype(jnp.float32)[None, :, None]
        outs.append(mean - uf[..., sl])
    p = jnp.stack(outs, axis=2).astype(u.dtype)
    y = jnp.einsum('blgc,gcd->blgd', p, w_grp).reshape(B, L, POOL_WIDTH)
    return y * scale


def hyena_filters(L, w1, b1, w2, b2, w3, b3, w4, b4, freq):
    f32 = jnp.float32
    t = jnp.linspace(0.0, 1.0, L, dtype=f32)[:, None]
    w = 2.0 * math.pi * jnp.arange(L, dtype=f32)[:, None] / L
    f = jnp.linspace(1e-4, HYENA_EMB_BANDS - 1, HYENA_EMB_BANDS, dtype=f32)[None, :]
    z = jnp.concatenate([t, jnp.cos(f * w), -jnp.sin(f * w)], axis=-1)
    fr = freq.astype(f32)
    h = jnp.sin(fr * (z @ w1.astype(f32) + b1.astype(f32)))
    h = jnp.sin(fr * (h @ w2.astype(f32) + b2.astype(f32)))
    h = jnp.sin(fr * (h @ w3.astype(f32) + b3.astype(f32)))
    h = h @ w4.astype(f32) + b4.astype(f32)
    min_decay = math.log(HYENA_TARGET) / HYENA_SLOW_DECAY
    max_decay = math.log(HYENA_TARGET) / HYENA_FAST_DECAY
    deltas = jnp.linspace(min_decay, max_decay, HYENA_WIDTH, dtype=f32)
    decay = jnp.exp(-t * jnp.abs(deltas)[None, :])
    h_f = h[:, :HYENA_WIDTH] * decay
    h_b = h[:, HYENA_WIDTH:] * decay
    k = jnp.concatenate([h_f, jnp.zeros((1, HYENA_WIDTH), f32), h_b[:0:-1]], axis=0)
    return k / jnp.sum(jnp.abs(k), axis=0, keepdims=True)


def hyena(u, conv_w, conv_b, w1, b1, w2, b2, w3, b3, w4, b4, freq, d_bias):
    B, L, _ = u.shape
    up = jnp.pad(u, ((0, 0), (1, 1), (0, 0)))
    uc = up[:, :-2] * conv_w[0] + up[:, 1:-1] * conv_w[1] + up[:, 2:] * conv_w[2] + conv_b
    x0, x1, v = jnp.split(uc, 3, axis=-1)
    k = hyena_filters(L, w1, b1, w2, b2, w3, b3, w4, b4, freq)
    v = (v * x1).astype(jnp.float32)
    vf = jnp.fft.rfft(v, n=2 * L, axis=1)
    kf = jnp.fft.rfft(k, axis=0)
    y = jnp.fft.irfft(vf * kf[None], n=2 * L, axis=1)[:, :L] + v * d_bias.astype(jnp.float32)
    return (y * x0.astype(jnp.float32)).astype(u.dtype)


def t5_buckets(rel):
    nb = N_BUCKETS // 2
    max_exact = nb // 2
    ret = (rel > 0).astype(jnp.int32) * nb
    n = jnp.abs(rel)
    large = max_exact + (jnp.log(jnp.maximum(n, 1).astype(jnp.float32) / max_exact)
                         / math.log(MAX_DISTANCE / max_exact) * (nb - max_exact)).astype(jnp.int32)
    large = jnp.minimum(large, nb - 1)
    return ret + jnp.where(n < max_exact, n, large)


def windowed_gqa(h, w_qkv, w_o, sink, rel_bias):
    B, L, _ = h.shape
    nb = L // BLOCK
    q, k, v = jnp.split(h @ w_qkv, [N_HEADS * HEAD_DIM, (N_HEADS + N_KV_HEADS) * HEAD_DIM], axis=-1)
    q = q.reshape(B, nb, BLOCK, N_KV_HEADS, GQA_GROUP, HEAD_DIM)

    def band(t):
        t = t.reshape(B, L, N_KV_HEADS, HEAD_DIM)
        t = jnp.pad(t, ((0, 0), (BLOCK, BLOCK), (0, 0), (0, 0))).reshape(B, nb + 2, BLOCK, N_KV_HEADS, HEAD_DIM)
        return jnp.concatenate([t[:, :-2], t[:, 1:-1], t[:, 2:]], axis=2)

    kb, vb = band(k), band(v)
    s = jnp.einsum('bnqkgd,bnpkd->bnkgqp', q, kb).astype(jnp.float32) / math.sqrt(HEAD_DIM)
    qi = jnp.arange(BLOCK)[:, None]
    pj = jnp.arange(3 * BLOCK)[None, :] - BLOCK
    rel = pj - qi
    bias = rel_bias.astype(jnp.float32)[t5_buckets(rel)]
    bias = bias.transpose(2, 0, 1).reshape(N_KV_HEADS, GQA_GROUP, BLOCK, 3 * BLOCK)
    kpos = jnp.arange(nb)[:, None] * BLOCK + pj
    valid = (jnp.abs(rel) <= WINDOW)[None] & ((kpos >= 0) & (kpos < L))[:, None, :]
    s = jnp.where(valid[None, :, None, None], s + bias, -jnp.inf)
    sink_l = sink.astype(jnp.float32).reshape(1, 1, N_KV_HEADS, GQA_GROUP, 1, 1)
    m = jnp.maximum(jnp.max(s, axis=-1, keepdims=True), sink_l)
    p = jnp.exp(s - m)
    p = p / (jnp.sum(p, axis=-1, keepdims=True) + jnp.exp(sink_l - m))
    o = jnp.einsum('bnkgqp,bnpkd->bnqkgd', p.astype(h.dtype), vb).reshape(B, L, N_HEADS * HEAD_DIM)
    return o @ w_o


def trunk(x, p):
    for layer in range(DEPTH):
        x = x + 0.5 * swiglu(rmsnorm(x, p['norm_ffn1'][layer]), p['ffn1_wi'][layer], p['ffn1_wo'][layer])
        h = rmsnorm(x, p['norm_mix'][layer])
        i = layer // 2
        if layer % 2 == 0:
            u = h @ p['ab_w_in'][i]
            ua, ub = u[..., :POOL_WIDTH], u[..., POOL_WIDTH:]
            ya = multiscale_pool(ua, p['pool_w'][i], p['pool_scale'][i])
            yb = hyena(ub, p['hy_conv_w'][i], p['hy_conv_b'][i],
                       p['hy_ff_w1'][i], p['hy_ff_b1'][i], p['hy_ff_w2'][i], p['hy_ff_b2'][i],
                       p['hy_ff_w3'][i], p['hy_ff_b3'][i], p['hy_ff_w4'][i], p['hy_ff_b4'][i],
                       p['hy_freq'][i], p['hy_d'][i])
            x = x + jnp.concatenate([ya, yb], axis=-1) @ p['ab_w_out'][i]
        else:
            x = x + windowed_gqa(h, p['attn_w_qkv'][i], p['attn_w_o'][i], p['attn_sink'][i], p['rel_bias'])
        x = x + 0.5 * swiglu(rmsnorm(x, p['norm_ffn2'][layer]), p['ffn2_wi'][layer], p['ffn2_wo'][layer])
    return rmsnorm(x, p['norm_final'])


def setup_inputs(seed: int = 0) -> dict:
    key = jax.random.key(seed)
    ks = jax.random.split(key, 32)
    f32 = jnp.float32

    def nrm(k, shape, scale):
        return jax.random.normal(k, shape, f32) * scale

    def gain(k, shape):
        return 1.0 + 0.05 * jax.random.normal(k, shape, f32)

    return {
        'x_prompt': nrm(ks[0], (BATCH, SEQ, D_MODEL), 1.0),
        'x_sample': nrm(ks[1], (DEC_BATCH, DEC_SEQ, D_MODEL), 1.0),
        'norm_ffn1': gain(ks[2], (DEPTH, D_MODEL)),
        'ffn1_wi': nrm(ks[3], (DEPTH, D_MODEL, 2 * D_FF), D_MODEL ** -0.5),
        'ffn1_wo': nrm(ks[4], (DEPTH, D_FF, D_MODEL), D_FF ** -0.5),
        'norm_mix': gain(ks[5], (DEPTH, D_MODEL)),
        'ab_w_in': nrm(ks[6], (N_EVEN, D_MODEL, AB_IN), D_MODEL ** -0.5),
        'pool_w': nrm(ks[7], (N_EVEN, N_POOL_GROUPS, POOL_GROUP, POOL_GROUP), POOL_GROUP ** -0.5),
        'pool_scale': 1.0 + 0.1 * jax.random.normal(ks[8], (N_EVEN, POOL_WIDTH), f32),
        'hy_conv_w': nrm(ks[9], (N_EVEN, 3, 3 * HYENA_WIDTH), 3 ** -0.5),
        'hy_conv_b': nrm(ks[10], (N_EVEN, 3 * HYENA_WIDTH), 0.02),
        'hy_ff_w1': nrm(ks[11], (N_EVEN, HYENA_EMB_DIM, HYENA_FILTER_ORDER), HYENA_EMB_DIM ** -0.5),
        'hy_ff_b1': nrm(ks[12], (N_EVEN, HYENA_FILTER_ORDER), 0.1),
        'hy_ff_w2': nrm(ks[13], (N_EVEN, HYENA_FILTER_ORDER, HYENA_FILTER_ORDER), HYENA_FILTER_ORDER ** -0.5),
        'hy_ff_b2': nrm(ks[14], (N_EVEN, HYENA_FILTER_ORDER), 0.1),
        'hy_ff_w3': nrm(ks[15], (N_EVEN, HYENA_FILTER_ORDER, HYENA_FILTER_ORDER), HYENA_FILTER_ORDER ** -0.5),
        'hy_ff_b3': nrm(ks[16], (N_EVEN, HYENA_FILTER_ORDER), 0.1),
        'hy_ff_w4': nrm(ks[17], (N_EVEN, HYENA_FILTER_ORDER, 2 * HYENA_WIDTH), HYENA_FILTER_ORDER ** -0.5),
        'hy_ff_b4': nrm(ks[18], (N_EVEN, 2 * HYENA_WIDTH), 0.1),
        'hy_freq': 1.0 + 0.1 * jax.random.normal(ks[19], (N_EVEN, HYENA_FILTER_ORDER), f32),
        'hy_d': nrm(ks[20], (N_EVEN, HYENA_WIDTH), 1.0),
        'ab_w_out': nrm(ks[21], (N_EVEN, D_MODEL, D_MODEL), D_MODEL ** -0.5),
        'attn_w_qkv': nrm(ks[22], (N_ODD, D_MODEL, QKV_OUT), D_MODEL ** -0.5),
        'attn_w_o': nrm(ks[23], (N_ODD, N_HEADS * HEAD_DIM, D_MODEL), (N_HEADS * HEAD_DIM) ** -0.5),
        'attn_sink': nrm(ks[24], (N_ODD, N_HEADS), 1.0),
        'rel_bias': nrm(ks[25], (N_BUCKETS, N_HEADS), 0.5),
        'norm_ffn2': gain(ks[26], (DEPTH, D_MODEL)),
        'ffn2_wi': nrm(ks[27], (DEPTH, D_MODEL, 2 * D_FF), D_MODEL ** -0.5),
        'ffn2_wo': nrm(ks[28], (DEPTH, D_FF, D_MODEL), D_FF ** -0.5),
        'norm_final': gain(ks[29], (D_MODEL,)),
    }


def reference(x_prompt, x_sample, norm_ffn1, ffn1_wi, ffn1_wo, norm_mix, ab_w_in, pool_w, pool_scale,
              hy_conv_w, hy_conv_b, hy_ff_w1, hy_ff_b1, hy_ff_w2, hy_ff_b2, hy_ff_w3, hy_ff_b3,
              hy_ff_w4, hy_ff_b4, hy_freq, hy_d, ab_w_out, attn_w_qkv, attn_w_o, attn_sink, rel_bias,
              norm_ffn2, ffn2_wi, ffn2_wo, norm_final):
    p = dict(norm_ffn1=norm_ffn1, ffn1_wi=ffn1_wi, ffn1_wo=ffn1_wo, norm_mix=norm_mix,
             ab_w_in=ab_w_in, pool_w=pool_w, pool_scale=pool_scale,
             hy_conv_w=hy_conv_w, hy_conv_b=hy_conv_b, hy_ff_w1=hy_ff_w1, hy_ff_b1=hy_ff_b1,
             hy_ff_w2=hy_ff_w2, hy_ff_b2=hy_ff_b2, hy_ff_w3=hy_ff_w3, hy_ff_b3=hy_ff_b3,
             hy_ff_w4=hy_ff_w4, hy_ff_b4=hy_ff_b4, hy_freq=hy_freq, hy_d=hy_d, ab_w_out=ab_w_out,
             attn_w_qkv=attn_w_qkv, attn_w_o=attn_w_o, attn_sink=attn_sink, rel_bias=rel_bias,
             norm_ffn2=norm_ffn2, ffn2_wi=ffn2_wi, ffn2_wo=ffn2_wo, norm_final=norm_final)
    y_prompt = trunk(x_prompt, p)
    y_sample = trunk(x_sample, p)
    return (y_prompt, y_sample)
```

```cpp
#include <hip/hip_runtime.h>
#include <cstdio>
#include <cstdint>

#ifndef MK_PER_PHASE
#define MK_PER_PHASE 0
#endif

#define LAS __attribute__((address_space(3)))
#define GAS __attribute__((address_space(1)))
typedef unsigned short bf16;
typedef short bf16x8 __attribute__((ext_vector_type(8)));
typedef float f32x4 __attribute__((ext_vector_type(4)));
typedef float f32x2 __attribute__((ext_vector_type(2)));
typedef unsigned u32x4 __attribute__((ext_vector_type(4)));
typedef unsigned u32x2 __attribute__((ext_vector_type(2)));
typedef float f32x16 __attribute__((ext_vector_type(16)));

constexpr int D = 2048, DFF = 5632, T = 24576, TP = 8192, LS = 2048, NSEQ_S = 8;
constexpr int NH = 16, NKV = 4, HD = 128, QKV = 3072, ABIN = 4096, PW = 1024, HW = 1024;
constexpr float EPS = 1e-6f;
constexpr int NPHASES = 32;

constexpr size_t SZ_WI = (size_t)2 * DFF * D * 2, SZ_WO = (size_t)D * DFF * 2;
constexpr size_t SZ_FFN = SZ_WI + SZ_WO;
constexpr size_t SZ_ABIN = (size_t)ABIN * D * 2, SZ_DD = (size_t)D * D * 2, SZ_POOL = (size_t)1024 * 256 * 2, SZ_QKV = (size_t)QKV * D * 2;
constexpr size_t SZ_MIX = SZ_ABIN + SZ_DD + SZ_POOL + SZ_QKV + SZ_DD;
constexpr size_t WS_CTL = 0, CTL_BYTES = 1u << 20;
constexpr size_t WS_W = CTL_BYTES;
constexpr size_t WS_WMIX = WS_W + 8 * SZ_FFN;
constexpr size_t WS_XB = WS_WMIX + 2 * SZ_MIX;
constexpr size_t WS_H = WS_XB + (size_t)T * D * 2;
constexpr size_t WS_AMIX = WS_H + (size_t)T * DFF * 2;
constexpr size_t WS_P = WS_AMIX + (size_t)T * D * 2;
constexpr size_t WS_X0 = WS_P + (size_t)T * 1024 * 2;
constexpr size_t WS_VV = WS_X0 + (size_t)T * 1024 * 2;
constexpr size_t SZ_KT1 = (size_t)(2 * TP + 2 * LS) * 1024 * 2;
constexpr size_t WS_KT = WS_VV + (size_t)T * 1024 * 2;
constexpr size_t WS_PART = WS_KT + 2 * SZ_KT1;
constexpr size_t WS_KPART = WS_PART + (size_t)T * 32 * 4;
constexpr size_t WS_R = WS_KPART + (size_t)2 * 320 * 2048 * 4;
constexpr size_t WS_END = WS_R + (size_t)(2 * TP + 2 * LS) * 1024 * 2;
constexpr size_t WS_VVT = WS_H + (size_t)T * ABIN * 2;
static_assert(WS_VVT + (size_t)T * 1024 * 2 <= WS_AMIX, "VVT must fit behind U in the H region");
static_assert(WS_END <= 1476395008ull, "workspace map exceeds 4x largest input");

constexpr int RING_BYTES = 131072, LDS_BYTES = 147456, MISC_OFF = LDS_BYTES - 256;

#define LDS_WAIT() asm volatile("s_waitcnt lgkmcnt(0)" ::: "memory")
#define VM_WAIT() asm volatile("s_waitcnt vmcnt(0)" ::: "memory")
__device__ __forceinline__ unsigned f2bf(float f) { unsigned u = __builtin_bit_cast(unsigned, f); return (u + 0x7fffu + ((u >> 16) & 1u)) >> 16; }
__device__ __forceinline__ unsigned pk2(float lo, float hi) { return f2bf(lo) | (f2bf(hi) << 16); }
__device__ __forceinline__ unsigned cvt_pk_bf16(float lo, float hi) { unsigned r; asm volatile("v_cvt_pk_bf16_f32 %0, %1, %2" : "=v"(r) : "v"(lo), "v"(hi)); return r; }
__device__ __forceinline__ float bflo(unsigned w) { return __builtin_bit_cast(float, w << 16); }
__device__ __forceinline__ float bfhi(unsigned w) { return __builtin_bit_cast(float, w & 0xffff0000u); }
__device__ __forceinline__ float bf1(bf16 b) { return __builtin_bit_cast(float, (unsigned)b << 16); }
__device__ __forceinline__ float wave_sum(float v) {
#pragma unroll
    for (int o = 1; o < 64; o <<= 1) v += __shfl_xor(v, o);
    return v;
}
__device__ __forceinline__ float wave_max(float v) {
#pragma unroll
    for (int o = 1; o < 64; o <<= 1) v = fmaxf(v, __shfl_xor(v, o));
    return v;
}

#define XB_TMO      128
#define XB_XCNT(j)  (256  + 64 * (j))
#define XB_XSUB(j)  (1280 + 64 * (j))
#define XB_XGEN(j)  (2304 + 64 * (j))
#define XB_TOP      3328
#define XB_TOPGEN   3392
#define XCD_BAR_WORDS 3456
#define XB_SPIN_CAP (1u << 18)
__device__ __forceinline__ unsigned xb_ld(unsigned* p)              { return __hip_atomic_load(p, __ATOMIC_RELAXED, __HIP_MEMORY_SCOPE_AGENT); }
__device__ __forceinline__ unsigned xb_add(unsigned* p, unsigned v) { return __hip_atomic_fetch_add(p, v, __ATOMIC_RELAXED, __HIP_MEMORY_SCOPE_AGENT); }
__device__ __forceinline__ unsigned xb_xcc_id() { return (unsigned)__builtin_amdgcn_s_getreg((3 << 11) | 20) & 0xFu; }
#define XB_SPIN(cond, bar) do { unsigned _sp = 0; while (cond) { __builtin_amdgcn_s_sleep(1); \
    if ((++_sp & 255u) == 0u) { if (xb_ld(&(bar)[XB_TMO])) break; if (_sp > XB_SPIN_CAP) { atomicAdd(&(bar)[XB_TMO], 1u); break; } } } } while (0)
struct XcdBarrier { unsigned* bar; unsigned x; volatile LAS unsigned* st; };
__device__ __forceinline__ XcdBarrier xcd_barrier_post(unsigned* bar, volatile LAS unsigned* st) {
    XcdBarrier b; b.bar = bar; b.x = xb_xcc_id(); b.st = st;
    if (threadIdx.x == 0) (void)xb_add(&bar[XB_XCNT(b.x)], 1u);
    return b;
}
__device__ __forceinline__ void xcd_barrier_complete(unsigned* bar, unsigned x, unsigned& nloc, unsigned& nx) {
    const unsigned G = gridDim.x * gridDim.y * gridDim.z;
    unsigned sum, cnt, mine, sp = 0u;
    for (;;) {
        sum = 0u; cnt = 0u; mine = 0u;
#pragma unroll
        for (unsigned j = 0; j < 16; ++j) { const unsigned c = xb_ld(&bar[XB_XCNT(j)]); sum += c; cnt += (c > 0u) ? 1u : 0u; mine = (j == x) ? c : mine; }
        if (sum == G) break;
        __builtin_amdgcn_s_sleep(1);
        if ((++sp & 255u) == 0u) { if (xb_ld(&bar[XB_TMO])) break; if (sp > XB_SPIN_CAP) { atomicAdd(&bar[XB_TMO], 1u); break; } }
    }
    nloc = mine > 0u ? mine : 1u; nx = cnt > 0u ? cnt : 1u;
}
__device__ __forceinline__ void xcd_barrier(const XcdBarrier& b) {
    asm volatile("s_waitcnt vmcnt(0)" ::: "memory");
    __syncthreads();
    if (threadIdx.x == 0) {
        unsigned* bar = b.bar;
        __builtin_amdgcn_s_waitcnt(0);
        unsigned nloc = b.st[0], nx = b.st[1];
        if (nloc == 0u) { xcd_barrier_complete(bar, b.x, nloc, nx); b.st[0] = nloc; b.st[1] = nx; }
        const unsigned old = xb_add(&bar[XB_XSUB(b.x)], 1u);
        const unsigned gen = old / nloc;
        if (old + 1u == (gen + 1u) * nloc) {
            __builtin_amdgcn_fence(__ATOMIC_RELEASE, "agent");
            asm volatile("s_waitcnt vmcnt(0)" ::: "memory");
            const unsigned og = xb_add(&bar[XB_TOP], 1u);
            const unsigned tg = og / nx;
            if (og + 1u == (tg + 1u) * nx) xb_add(&bar[XB_TOPGEN], 1u);
            else XB_SPIN(xb_ld(&bar[XB_TOPGEN]) == tg, bar);
            __builtin_amdgcn_fence(__ATOMIC_ACQUIRE, "agent");
            xb_add(&bar[XB_XGEN(b.x)], 1u);
            asm volatile("s_waitcnt vmcnt(0)" ::: "memory");
        } else {
            XB_SPIN(xb_ld(&bar[XB_XGEN(b.x)]) == gen, bar);
            __builtin_amdgcn_fence(__ATOMIC_ACQUIRE, "agent");
            asm volatile("s_waitcnt vmcnt(0)" ::: "memory");
        }
    }
    __syncthreads();
}

namespace pg8 {
constexpr int BM = 256, BK = 64, HALF = 128, HTB = HALF * BK * 2, STAGE_BYTES = 8 * HTB, NXCD = 8, WGM = 8;
__host__ __device__ __forceinline__ int lds_byte(int r, int c) { const int st = (r >> 4) * 2 + (c >> 5), rr = r & 15, cc = c & 31, ob = rr * 64 + cc * 2; return st * 1024 + (ob ^ (((ob >> 9) & 1) << 5)); }
__host__ __device__ __forceinline__ void stage_rc(int b, int& R, int& C) { const int st = b / 1024, sb = b % 1024, swz = sb ^ (((sb >> 9) & 1) << 5); R = (st >> 1) * 16 + swz / 64; C = (st & 1) * 32 + (swz % 64) / 2; }
__host__ __device__ __forceinline__ int perm32(int rho) { const int n = rho >> 4, i = rho & 15; return 8 * (i >> 2) + 4 * n + (i & 3); }
struct Unit { int pm, pn; };
struct Gemm { const bf16* A; const bf16* Bt; int M, N, K, lda, ldb, acs; };
struct StaticOrder {
    int nM, nN, nwg, G, c, wgm, rev;
    __device__ void init(int M, int N, int G_, int c_, int rev_ = 0) { nM = M / BM; nN = N / BM; nwg = nM * nN; G = G_; c = c_; wgm = (nN == 8) ? 4 : WGM; rev = rev_; }
    __device__ bool next(int i, Unit& u) const {
        const long L = (long)i * G + c; if (L >= nwg) return false;
        int wgid = (int)L; { const int q = nwg / NXCD, r = nwg % NXCD, xcd = wgid % NXCD, off = wgid / NXCD; wgid = (xcd < r ? xcd * (q + 1) : r * (q + 1) + (xcd - r) * q) + off; }
        const int nig = wgm * nN, gid = wgid / nig, fm = gid * wgm, gsz = (nM - fm) < wgm ? (nM - fm) : wgm;
        u.pm = fm + ((wgid % nig) % gsz); u.pn = (wgid % nig) / gsz; if (rev) u.pm = nM - 1 - u.pm; return true;
    }
};
template <class Epi, bool ALIGN_EPI>
__device__ __forceinline__ void gemm_phase(LAS unsigned char* lds, const Gemm g, const StaticOrder& S, const Epi& E, const int tid) {
    const int wid = __builtin_amdgcn_readfirstlane(tid >> 6), lane = tid & 63, wr = wid >> 2, wc = wid & 3, fr = lane & 15, fq = lane >> 4;
    const int K = g.K, nt = K / BK;
    unsigned voffA[2], voffB[2];
#pragma unroll
    for (int i = 0; i < 2; ++i) { int R, C; stage_rc(tid * 16 + i * 8192, R, C); const int Rb = (R & ~31) + perm32(R & 31);
        voffA[i] = (unsigned)(R * g.lda + C) * 2u; voffB[i] = (unsigned)(Rb * g.ldb + C) * 2u; }
    const size_t kstep = (size_t)(BK * 2);
    const size_t hstepA = (size_t)HALF * g.lda * 2, hstepB = (size_t)HALF * g.ldb * 2;
    const size_t tstepA = 2 * hstepA, tstepB = 2 * hstepB;
    const unsigned ldsw = (unsigned)wid * 1024u;
    const int aoff = lds_byte(wr * 64 + fr, fq * 8), boff = lds_byte(wc * 32 + fr, fq * 8);
#define PG8_SA(b, h) (((b) * 2 + (h)) * HTB)
#define PG8_SB(b, h) ((4 + (b) * 2 + (h)) * HTB)
#define PG8_STAGE(bufoff, gbase, voff) do { _Pragma("unroll") for (int _i = 0; _i < 2; ++_i) \
        __builtin_amdgcn_global_load_lds((const unsigned*)((const char*)(gbase) + (voff)[_i]), (LAS unsigned*)(lds + (bufoff) + ldsw + _i * 8192), 16, 0, 0); } while (0)
#define PG8_LDA(dst, b, h) do { _Pragma("unroll") for (int m = 0; m < 4; ++m) _Pragma("unroll") for (int k = 0; k < 2; ++k) dst[m][k] = *(const LAS bf16x8*)(lds + PG8_SA(b, h) + aoff + m * 2048 + k * 1024); } while (0)
#define PG8_LDB(dst, b, h) do { _Pragma("unroll") for (int n = 0; n < 2; ++n) _Pragma("unroll") for (int k = 0; k < 2; ++k) dst[n][k] = *(const LAS bf16x8*)(lds + PG8_SB(b, h) + boff + n * 2048 + k * 1024); } while (0)
#define PG8_MMA(ai, bj, At, Bt) do { __builtin_amdgcn_s_setprio(1); _Pragma("unroll") for (int m = 0; m < 4; ++m) _Pragma("unroll") for (int n = 0; n < 2; ++n) _Pragma("unroll") for (int k = 0; k < 2; ++k) \
        acc[ai][bj][m][n] = __builtin_amdgcn_mfma_f32_16x16x32_bf16(Bt[n][k], At[m][k], acc[ai][bj][m][n], 0, 0, 0); __builtin_amdgcn_s_setprio(0); } while (0)
#define PG8_WAIT_V(n) asm volatile("s_waitcnt vmcnt(" #n ")" ::: "memory")
#define PG8_WAIT_L(n) asm volatile("s_waitcnt lgkmcnt(" #n ")" ::: "memory")
#define PG8_BAR __builtin_amdgcn_s_barrier()
#define PG8_SCHED __builtin_amdgcn_sched_barrier(0)
    Unit cur, nxt; int ui = 0; int rs_pm = -1;
    if (!S.next(0, cur)) return;
    f32x4 acc[2][2][4][2];
#pragma unroll
    for (int a = 0; a < 2; ++a)
#pragma unroll
        for (int b = 0; b < 2; ++b)
#pragma unroll
            for (int m = 0; m < 4; ++m)
#pragma unroll
                for (int n = 0; n < 2; ++n) acc[a][b][m][n] = (f32x4){0.f, 0.f, 0.f, 0.f};
    bf16x8 At[4][2], B0[2][2], B1[2][2];
    const char* cA = (const char*)g.A + (size_t)cur.pm * tstepA + (size_t)cur.pn * g.acs; const char* cB = (const char*)g.Bt + (size_t)cur.pn * tstepB;
    PG8_STAGE(PG8_SB(0, 0), cB, voffB); PG8_STAGE(PG8_SB(0, 1), cB + hstepB, voffB); PG8_STAGE(PG8_SA(0, 0), cA, voffA); PG8_STAGE(PG8_SA(0, 1), cA + hstepA, voffA);
    if (wr == 1) PG8_BAR;
    PG8_WAIT_V(2); PG8_BAR;
    PG8_STAGE(PG8_SB(1, 0), cB + kstep, voffB); PG8_STAGE(PG8_SA(1, 0), cA + kstep, voffA); PG8_STAGE(PG8_SB(1, 1), cB + hstepB + kstep, voffB);
    PG8_WAIT_V(6); PG8_BAR;
    for (;;) {
        const bool has_next = S.next(ui + 1, nxt);
        const char* nA = has_next ? (const char*)g.A + (size_t)nxt.pm * tstepA + (size_t)nxt.pn * g.acs : cA; const char* nB = has_next ? (const char*)g.Bt + (size_t)nxt.pn * tstepB : cB;
        for (int t = 0; t < nt; t += 2) {
            const bool last = (t == nt - 2);
            const char* a1 = cA + (size_t)(t + 1) * kstep;
            const char* a2 = last ? nA : cA + (size_t)(t + 2) * kstep; const char* b2 = last ? nB : cB + (size_t)(t + 2) * kstep;
            const char* a3 = a2 + kstep; const char* b3 = b2 + kstep;
            PG8_LDB(B0, 0, 0); PG8_LDB(B1, 0, 1); PG8_SCHED; PG8_LDA(At, 0, 0); PG8_STAGE(PG8_SA(1, 1), a1 + hstepA, voffA);
            PG8_WAIT_V(8); PG8_WAIT_L(0); PG8_BAR; PG8_MMA(0, 0, At, B0); PG8_MMA(0, 1, At, B1); PG8_BAR; PG8_SCHED;
            PG8_LDA(At, 0, 1); PG8_STAGE(PG8_SB(0, 0), b2, voffB); PG8_STAGE(PG8_SB(0, 1), b2 + hstepB, voffB); PG8_STAGE(PG8_SA(0, 0), a2, voffA);
            PG8_WAIT_V(8); PG8_WAIT_L(0); PG8_BAR; PG8_MMA(1, 0, At, B0); PG8_MMA(1, 1, At, B1); PG8_BAR; PG8_SCHED;
            PG8_LDB(B0, 1, 0); PG8_LDB(B1, 1, 1); PG8_SCHED; PG8_LDA(At, 1, 0); PG8_STAGE(PG8_SA(0, 1), a2 + hstepA, voffA);
            PG8_WAIT_V(8); PG8_WAIT_L(0); PG8_BAR; PG8_MMA(0, 0, At, B0); PG8_MMA(0, 1, At, B1); PG8_BAR; PG8_SCHED;
            PG8_LDA(At, 1, 1); PG8_STAGE(PG8_SB(1, 0), b3, voffB); PG8_STAGE(PG8_SB(1, 1), b3 + hstepB, voffB); PG8_STAGE(PG8_SA(1, 0), a3, voffA);
            PG8_WAIT_V(8); PG8_WAIT_L(0); PG8_BAR; PG8_MMA(1, 0, At, B0); PG8_MMA(1, 1, At, B1); PG8_BAR; PG8_SCHED;
        }
        if constexpr (ALIGN_EPI) { if (wr == 0) PG8_BAR; }
        E(acc, cur, wr, wc, lds, rs_pm);
        if (!has_next) break;
        cur = nxt; cA = nA; cB = nB; ++ui;
        if constexpr (ALIGN_EPI) { if (wr == 1) PG8_BAR; }
    }
    PG8_WAIT_V(0);
    if constexpr (!ALIGN_EPI) { if (wr == 0) PG8_BAR; }
    PG8_BAR;
#undef PG8_SA
#undef PG8_SB
#undef PG8_STAGE
#undef PG8_LDA
#undef PG8_LDB
#undef PG8_MMA
#undef PG8_WAIT_V
#undef PG8_WAIT_L
#undef PG8_BAR
#undef PG8_SCHED
}

__device__ __forceinline__ u32x4 zero_frag() { unsigned z_ = 0u; asm volatile("" : "+v"(z_)); return (u32x4){z_, z_, z_, z_}; }
__device__ __forceinline__ void zero_acc(f32x4& a, u32x4& zb) { asm volatile("" : "+v"(zb));
    a = __builtin_amdgcn_mfma_f32_16x16x32_bf16(__builtin_bit_cast(bf16x8, zb), __builtin_bit_cast(bf16x8, zb), (f32x4){0.f, 0.f, 0.f, 0.f}, 0, 0, 0); }
__device__ __forceinline__ void epi_lane(int& fr, int& fq) { unsigned ones = ~0u; asm volatile("" : "+s"(ones)); const int ln = (int)__builtin_amdgcn_mbcnt_hi(ones, __builtin_amdgcn_mbcnt_lo(ones, 0u)); fr = ln & 15; fq = ln >> 4; }
__device__ __forceinline__ void load_rs(const float* part, int row0, int fq, float (&rs)[2][4]) {
#pragma unroll
    for (int ai = 0; ai < 2; ++ai)
#pragma unroll
        for (int m = 0; m < 4; ++m) {
            const f32x4* p = (const f32x4*)(part + (size_t)(row0 + ai * HALF + m * 16) * 32 + fq * 8);
            const f32x4 a = p[0], b = p[1];
            float s = ((a[0] + a[1]) + (a[2] + a[3])) + ((b[0] + b[1]) + (b[2] + b[3]));
            s += __shfl_xor(s, 16); s += __shfl_xor(s, 32);
            rs[ai][m] = __builtin_amdgcn_rsqf(s * (1.0f / D) + EPS);
        }
}
__device__ __forceinline__ void load_rs_cached(const float* part, int pm, int row0, int wid, int fr, int fq, LAS unsigned char* lds, int& rs_pm, float (&rs)[2][4]) {
    LAS float* rc = (LAS float*)(lds + RING_BYTES) + wid * 128 + fr;
    if (pm != rs_pm) {
        load_rs(part, row0, fq, rs); rs_pm = pm;
        if (fq == 0) {
#pragma unroll
            for (int q = 0; q < 8; ++q) rc[q * 16] = rs[q >> 2][q & 3]; }
    } else {
#pragma unroll
        for (int q = 0; q < 8; ++q) rs[q >> 2][q & 3] = rc[q * 16];
    }
}
struct EpiSwiGLU {
    bf16* H; const float* part;
    __device__ __forceinline__ void operator()(f32x4 (&acc)[2][2][4][2], const Unit& u, int wr, int wc, LAS unsigned char* lds, int& rs_pm) const {
        int fr, fq; epi_lane(fr, fq);
        const int row0 = u.pm * BM + wr * 64 + fr, col0 = u.pn * HALF + wc * 32 + 8 * fq;
        float rs[2][4]; load_rs_cached(part, u.pm, row0, wr * 4 + wc, fr, fq, lds, rs_pm, rs);
        u32x4 zb = zero_frag();
#pragma unroll
        for (int ai = 0; ai < 2; ++ai)
#pragma unroll
            for (int m = 0; m < 4; ++m) {
                const float r = rs[ai][m], rsn = r * -1.4426950408889634f, rs2 = r * r; float o[8];
                f32x4 av[2], gu[2];
#pragma unroll
                for (int n = 0; n < 2; ++n) { av[n] = acc[ai][0][m][n] * rsn; gu[n] = acc[ai][0][m][n] * acc[ai][1][m][n]; }
#pragma unroll
                for (int n = 0; n < 2; ++n) { zero_acc(acc[ai][0][m][n], zb); zero_acc(acc[ai][1][m][n], zb); }
#pragma unroll
                for (int n = 0; n < 2; ++n)
#pragma unroll
                    for (int j = 0; j < 4; ++j) av[n][j] = __builtin_amdgcn_exp2f(av[n][j]);
#pragma unroll
                for (int n = 0; n < 2; ++n) av[n] = av[n] + 1.0f;
#pragma unroll
                for (int n = 0; n < 2; ++n)
#pragma unroll
                    for (int j = 0; j < 4; ++j) av[n][j] = __builtin_amdgcn_rcpf(av[n][j]);
#pragma unroll
                for (int n = 0; n < 2; ++n) { const f32x4 q = gu[n] * (av[n] * rs2);
#pragma unroll
                    for (int j = 0; j < 4; ++j) o[n * 4 + j] = q[j]; }
                u32x4 w; w.x = cvt_pk_bf16(o[0], o[1]); w.y = cvt_pk_bf16(o[2], o[3]); w.z = cvt_pk_bf16(o[4], o[5]); w.w = cvt_pk_bf16(o[6], o[7]);
                *(u32x4*)(H + (size_t)(row0 + ai * HALF + m * 16) * DFF + col0) = w;
            }
    }
};
struct EpiScale {
    bf16* O; int ldc; const float* part;
    __device__ __forceinline__ void operator()(f32x4 (&acc)[2][2][4][2], const Unit& u, int wr, int wc, LAS unsigned char* lds, int& rs_pm) const {
        int fr, fq; epi_lane(fr, fq);
        const int row0 = u.pm * BM + wr * 64 + fr, col0 = u.pn * BM + wc * 32 + 8 * fq;
        float rs[2][4]; load_rs_cached(part, u.pm, row0, wr * 4 + wc, fr, fq, lds, rs_pm, rs);
        u32x4 zb = zero_frag();
#pragma unroll
        for (int ai = 0; ai < 2; ++ai)
#pragma unroll
            for (int m = 0; m < 4; ++m) { const float r = rs[ai][m]; bf16* rowp = O + (size_t)(row0 + ai * HALF + m * 16) * ldc + col0;
#pragma unroll
                for (int bj = 0; bj < 2; ++bj) { const f32x4 v0 = acc[ai][bj][m][0] * r, v1 = acc[ai][bj][m][1] * r; zero_acc(acc[ai][bj][m][0], zb); zero_acc(acc[ai][bj][m][1], zb);
                    u32x4 w; w.x = cvt_pk_bf16(v0[0], v0[1]); w.y = cvt_pk_bf16(v0[2], v0[3]); w.z = cvt_pk_bf16(v1[0], v1[1]); w.w = cvt_pk_bf16(v1[2], v1[3]);
                    *(u32x4*)(rowp + bj * HALF) = w; } }
    }
};
struct EpiColScale {
    bf16* O; int ldc; const float* cs;
    __device__ __forceinline__ void operator()(f32x4 (&acc)[2][2][4][2], const Unit& u, int wr, int wc, LAS unsigned char* lds, int& rs_pm) const {
        int fr, fq; epi_lane(fr, fq);
        const int row0 = u.pm * BM + wr * 64 + fr, col0 = u.pn * BM + wc * 32 + 8 * fq;
        f32x4 sv[2][2]; u32x4 zb = zero_frag();
#pragma unroll
        for (int bj = 0; bj < 2; ++bj)
#pragma unroll
            for (int n = 0; n < 2; ++n) sv[bj][n] = *(const f32x4*)(cs + col0 + bj * HALF + 4 * n);
#pragma unroll
        for (int ai = 0; ai < 2; ++ai)
#pragma unroll
            for (int m = 0; m < 4; ++m) { bf16* rowp = O + (size_t)(row0 + ai * HALF + m * 16) * ldc + col0;
#pragma unroll
                for (int bj = 0; bj < 2; ++bj) { const f32x4 v0 = acc[ai][bj][m][0] * sv[bj][0], v1 = acc[ai][bj][m][1] * sv[bj][1]; zero_acc(acc[ai][bj][m][0], zb); zero_acc(acc[ai][bj][m][1], zb);
                    u32x4 w; w.x = cvt_pk_bf16(v0[0], v0[1]); w.y = cvt_pk_bf16(v0[2], v0[3]); w.z = cvt_pk_bf16(v1[0], v1[1]); w.w = cvt_pk_bf16(v1[2], v1[3]);
                    *(u32x4*)(rowp + bj * HALF) = w; } }
    }
};
struct EpiResid {
    bf16* xb; float* part; float alpha;
    __device__ __forceinline__ void operator()(f32x4 (&acc)[2][2][4][2], const Unit& u, int wr, int wc, LAS unsigned char* lds, int& rs_pm) const {
        int fr, fq; epi_lane(fr, fq);
        const int row0 = u.pm * BM + wr * 64 + fr, col0 = u.pn * BM + wc * 32 + 8 * fq; u32x4 zb = zero_frag();
#pragma unroll
        for (int ai = 0; ai < 2; ++ai)
#pragma unroll
            for (int m = 0; m < 4; ++m) { const size_t oo = (size_t)(row0 + ai * HALF + m * 16) * D + col0; float ss = 0.f;
#pragma unroll
                for (int bj = 0; bj < 2; ++bj) {
                    const u32x4 xw = *(const u32x4*)(xb + oo + bj * HALF);
                    const f32x4 x0 = (f32x4){bflo(xw.x), bfhi(xw.x), bflo(xw.y), bfhi(xw.y)}, x1 = (f32x4){bflo(xw.z), bfhi(xw.z), bflo(xw.w), bfhi(xw.w)};
                    const f32x4 v0 = x0 + acc[ai][bj][m][0] * alpha, v1 = x1 + acc[ai][bj][m][1] * alpha; zero_acc(acc[ai][bj][m][0], zb); zero_acc(acc[ai][bj][m][1], zb);
                    ss += (v0[0] * v0[0] + v0[1] * v0[1]) + (v0[2] * v0[2] + v0[3] * v0[3]) + (v1[0] * v1[0] + v1[1] * v1[1]) + (v1[2] * v1[2] + v1[3] * v1[3]);
                    u32x4 w; w.x = cvt_pk_bf16(v0[0], v0[1]); w.y = cvt_pk_bf16(v0[2], v0[3]); w.z = cvt_pk_bf16(v1[0], v1[1]); w.w = cvt_pk_bf16(v1[2], v1[3]);
                    *(u32x4*)(xb + oo + bj * HALF) = w; }
                ss += __shfl_xor(ss, 16); ss += __shfl_xor(ss, 32);
                if (fq == 0) part[(size_t)(row0 + ai * HALF + m * 16) * 32 + u.pn * 4 + wc] = ss;
                asm volatile("" ::: "memory"); }
    }
};
}


namespace att {
typedef short s16x4 __attribute__((ext_vector_type(4)));
constexpr int SHM_V = 64 * 128 * 2, SHM_K = 64 * 128 * 2;
#define ATT_KSWZ(row, colB) ((row) * 256 + ((colB) ^ (((row) & 7) << 4)))
__device__ __forceinline__ int crow(int r, int hi) { return (r & 3) + 8 * (r >> 2) + 4 * hi; }
__device__ __forceinline__ int v_st(int k, int c) { const int kk = (k & ~0xC) | ((k & 4) << 1) | ((k & 8) >> 1); return ((kk >> 3) * 4 + (c >> 5)) * 512 + ((kk & 7) * 32 + (c & 31)) * 2; }
__device__ __forceinline__ int v_rd_base(int lane) { return ((lane & 3) << 3) | (((lane >> 2) & 3) << 6) | (((lane >> 4) & 1) << 5) | (((lane >> 5) & 1) << 8); }
constexpr int v_rd_off(int d0, int ks, int half) { return d0 * 512 + ks * 4096 + half * 2048; }
template <int OFF> __device__ __forceinline__ s16x4 tr_read(int vb) {
    s16x4 r; asm volatile("ds_read_b64_tr_b16 %0, %1 offset:%2" : "=&v"(r) : "v"(vb), "i"(OFF) : "memory"); return r;
}
template <int D0> __device__ __forceinline__ void pv_one(f32x16& od, int vb, bf16x8 pa0, bf16x8 pa1, bf16x8 pa2, bf16x8 pa3) {
    const s16x4 l0 = tr_read<v_rd_off(D0, 0, 0)>(vb), h0 = tr_read<v_rd_off(D0, 0, 1)>(vb), l1 = tr_read<v_rd_off(D0, 1, 0)>(vb), h1 = tr_read<v_rd_off(D0, 1, 1)>(vb);
    const s16x4 l2 = tr_read<v_rd_off(D0, 2, 0)>(vb), h2 = tr_read<v_rd_off(D0, 2, 1)>(vb), l3 = tr_read<v_rd_off(D0, 3, 0)>(vb), h3 = tr_read<v_rd_off(D0, 3, 1)>(vb);
    asm volatile("s_waitcnt lgkmcnt(0)" ::: "memory"); __builtin_amdgcn_sched_barrier(0);
#define ATT_PK(L, H) (bf16x8){L[0], L[1], L[2], L[3], H[0], H[1], H[2], H[3]}
    od = __builtin_amdgcn_mfma_f32_32x32x16_bf16(pa0, ATT_PK(l0, h0), od, 0, 0, 0);
    od = __builtin_amdgcn_mfma_f32_32x32x16_bf16(pa1, ATT_PK(l1, h1), od, 0, 0, 0);
    od = __builtin_amdgcn_mfma_f32_32x32x16_bf16(pa2, ATT_PK(l2, h2), od, 0, 0, 0);
    od = __builtin_amdgcn_mfma_f32_32x32x16_bf16(pa3, ATT_PK(l3, h3), od, 0, 0, 0);
#undef ATT_PK
}
__device__ __forceinline__ int t5_bucket(int rel) { const int n = rel < 0 ? -rel : rel; int bk = rel > 0 ? 16 : 0;
    if (n < 8) bk += n; else { const int lg = (31 - __builtin_clz((unsigned)(n * n))) - 6; bk += min(8 + lg, 15); } return bk; }

__device__ __forceinline__ void attn_unit(const bf16* QKVb, bf16* AMIXb, const float* sinkp, const float* relb, int u, LAS unsigned char* lds, int tid, int lane, int wave, int& tab_key) {
    asm volatile("" : "+v"(lane));
    const int gb = u >> 3, kv = (u >> 1) & 3, hp = u & 1;
    int s0, nblk, nb; if (gb < 64) { s0 = 0; nblk = 64; nb = gb; } else { const int r = gb - 64; s0 = TP + (r >> 4) * LS; nblk = 16; nb = r & 15; }
    const int r32 = lane & 31, hi = lane >> 5, hsel = wave >> 2, qa = wave & 3, head = kv * 4 + hp * 2 + hsel;
    const int q0 = s0 + nb * 128;
    LAS unsigned char* V_lds = lds; LAS unsigned char* K_lds = lds + 2 * SHM_V;
    LAS float* wsc = (LAS float*)(lds + 2 * SHM_V + 2 * SHM_K) + wave * 64; LAS float* tab = (LAS float*)(lds + 2 * SHM_V + 2 * SHM_K + 2048);
    constexpr float LOG2E = 1.4426950408889634f, C = 0.08838834764831845f * LOG2E;
    __syncthreads();
    if ((u & 7) != tab_key) { tab_key = u & 7;
    for (int e = tid; e < 1024; e += 512) { const int hs = e >> 9, idx = e & 511, rel = idx - 255; float v = -1e30f;
        if (rel >= -128 && rel <= 128) v = relb[t5_bucket(rel) * 16 + kv * 4 + hp * 2 + hs] * LOG2E;
        tab[e] = v; } }
    const bf16* Qw = QKVb + (size_t)(q0 + qa * 32 + r32) * QKV + head * 128 + hi * 8;
    bf16x8 qr[8];
#pragma unroll
    for (int d0 = 0; d0 < 8; ++d0) qr[d0] = *(const bf16x8*)(Qw + d0 * 16);
    const int jfirst = nb > 0 ? 0 : 2, jlast = nb < nblk - 1 ? 5 : 3;
    const bf16* Kg = QKVb + 2048 + kv * 128; const bf16* Vg = QKVb + 2560 + kv * 128;
    const int sr = tid >> 4, sc = (tid & 15) * 8, vst0 = v_st(sr, sc), vst1 = v_st(32 + sr, sc);
    const int vb0 = (int)(unsigned)(uintptr_t)V_lds + v_rd_base(lane);
    bf16x8 ks0, ks1, vs0, vs1;
#define ATT_TKEY(j) (q0 + ((j) >> 1) * 128 - 128 + ((j) & 1) * 64)
#define ATT_SLOAD(j) do { const size_t k0_ = (size_t)ATT_TKEY(j); ks0 = *(const bf16x8*)(Kg + (k0_ + sr) * QKV + sc); ks1 = *(const bf16x8*)(Kg + (k0_ + 32 + sr) * QKV + sc); \
        vs0 = *(const bf16x8*)(Vg + (k0_ + sr) * QKV + sc); vs1 = *(const bf16x8*)(Vg + (k0_ + 32 + sr) * QKV + sc); } while (0)
#define ATT_SWRITE(b) do { *(LAS bf16x8*)(V_lds + (b) * SHM_V + vst0) = vs0; *(LAS bf16x8*)(V_lds + (b) * SHM_V + vst1) = vs1; \
        *(LAS bf16x8*)(K_lds + (b) * SHM_K + ATT_KSWZ(sr, sc * 2)) = ks0; *(LAS bf16x8*)(K_lds + (b) * SHM_K + ATT_KSWZ(32 + sr, sc * 2)) = ks1; } while (0)
    const float sink2 = sinkp[head] * LOG2E;
    float m_reg = sink2, l_reg = 0.f;
    f32x16 o[4];
#pragma unroll
    for (int d = 0; d < 4; ++d)
#pragma unroll
        for (int r = 0; r < 16; ++r) o[d][r] = 0.f;
    ATT_SLOAD(jfirst); asm volatile("s_waitcnt vmcnt(0)" ::: "memory"); ATT_SWRITE(0); __syncthreads();
    for (int j = jfirst; j <= jlast; ++j) {
        const int b = (j - jfirst) & 1;
        if (j < jlast) ATT_SLOAD(j + 1);
        if (!((j == 0 && qa >= 2) || (j == 5 && qa < 2))) {
        f32x16 p0, p1;
#pragma unroll
        for (int r = 0; r < 16; ++r) { p0[r] = 0.f; p1[r] = 0.f; }
        { const LAS unsigned char* Ks = K_lds + b * SHM_K;
#pragma unroll
          for (int d0 = 0; d0 < 8; ++d0) { const int cb = (d0 * 16 + hi * 8) * 2;
              const bf16x8 b0 = *(const LAS bf16x8*)(Ks + ATT_KSWZ(r32, cb)), b1 = *(const LAS bf16x8*)(Ks + ATT_KSWZ(32 + r32, cb));
              p0 = __builtin_amdgcn_mfma_f32_32x32x16_bf16(b0, qr[d0], p0, 0, 0, 0);
              p1 = __builtin_amdgcn_mfma_f32_32x32x16_bf16(b1, qr[d0], p1, 0, 0, 0); } }
        { const int koff = ((j >> 1) - 1) * 128 + (j & 1) * 64;
          const LAS float* tb = tab + hsel * 512 + (koff - (qa * 32 + r32) + 255 + 4 * hi);
#pragma unroll
          for (int r = 0; r < 16; ++r) { p0[r] = fmaf(p0[r], C, tb[(r & 3) + 8 * (r >> 2)]); p1[r] = fmaf(p1[r], C, tb[32 + (r & 3) + 8 * (r >> 2)]); } }
        float pmax = p0[0];
#pragma unroll
        for (int r = 1; r < 16; ++r) pmax = fmaxf(pmax, p0[r]);
#pragma unroll
        for (int r = 0; r < 16; ++r) pmax = fmaxf(pmax, p1[r]);
        { auto rr = __builtin_amdgcn_permlane32_swap(__float_as_uint(pmax), __float_as_uint(pmax), false, false); pmax = fmaxf(__uint_as_float(rr[0]), __uint_as_float(rr[1])); }
        const float mn = fmaxf(m_reg, pmax), alpha = __builtin_amdgcn_exp2f(m_reg - mn); m_reg = mn;
        float ps = 0.f;
#pragma unroll
        for (int r = 0; r < 16; ++r) { p0[r] = __builtin_amdgcn_exp2f(p0[r] - mn); p1[r] = __builtin_amdgcn_exp2f(p1[r] - mn); ps += p0[r] + p1[r]; }
        { auto rr = __builtin_amdgcn_permlane32_swap(__float_as_uint(ps), __float_as_uint(ps), false, false); ps = __uint_as_float(rr[0]) + __uint_as_float(rr[1]); }
        l_reg = l_reg * alpha + ps;
        if (__any(alpha < 1.f)) { if (hi == 0) wsc[r32] = alpha; asm volatile("s_waitcnt lgkmcnt(0)" ::: "memory");
#pragma unroll
            for (int r = 0; r < 16; ++r) { const float al = wsc[crow(r, hi)];
#pragma unroll
                for (int d = 0; d < 4; ++d) o[d][r] *= al; }
            asm volatile("s_waitcnt lgkmcnt(0)" ::: "memory"); }
        bf16x8 pa0, pa1, pa2, pa3;
#define ATT_PK4(P, BASE, OUT) do { unsigned a0 = cvt_pk_bf16(P[BASE + 0], P[BASE + 1]), a1 = cvt_pk_bf16(P[BASE + 2], P[BASE + 3]);   \
        unsigned b0 = cvt_pk_bf16(P[BASE + 4], P[BASE + 5]), b1 = cvt_pk_bf16(P[BASE + 6], P[BASE + 7]);                              \
        auto r0 = __builtin_amdgcn_permlane32_swap(a0, b0, false, false); auto r1 = __builtin_amdgcn_permlane32_swap(a1, b1, false, false); \
        u32x4 w = {r0[0], r1[0], r0[1], r1[1]}; OUT = __builtin_bit_cast(bf16x8, w); } while (0)
        ATT_PK4(p0, 0, pa0); ATT_PK4(p0, 8, pa1); ATT_PK4(p1, 0, pa2); ATT_PK4(p1, 8, pa3);
#undef ATT_PK4
        { const int vb = vb0 + b * SHM_V;
          pv_one<0>(o[0], vb, pa0, pa1, pa2, pa3); pv_one<1>(o[1], vb, pa0, pa1, pa2, pa3); pv_one<2>(o[2], vb, pa0, pa1, pa2, pa3); pv_one<3>(o[3], vb, pa0, pa1, pa2, pa3); }
        }
        if (j < jlast) { asm volatile("s_waitcnt vmcnt(0)" ::: "memory"); ATT_SWRITE(b ^ 1); }
        __syncthreads();
    }
    l_reg += __builtin_amdgcn_exp2f(sink2 - m_reg);
    if (hi == 0) wsc[r32] = l_reg; asm volatile("s_waitcnt lgkmcnt(0)" ::: "memory");
    bf16* Ow = AMIXb + (size_t)(q0 + qa * 32) * D + head * 128 + r32;
#pragma unroll
    for (int r = 0; r < 16; ++r) { const int orow = crow(r, hi); const float rl = __builtin_amdgcn_rcpf(wsc[orow]);
#pragma unroll
        for (int d0 = 0; d0 < 4; ++d0) Ow[(size_t)orow * D + d0 * 32] = (bf16)f2bf(o[d0][r] * rl); }
    asm volatile("s_waitcnt lgkmcnt(0)" ::: "memory");
#undef ATT_TKEY
#undef ATT_SLOAD
#undef ATT_SWRITE
}
}

struct Args { const float* in[30]; float* out; unsigned char* ws; int ph_lo, ph_hi; };
typedef const Args __attribute__((address_space(4)))* KArgs;
enum { I_XP = 0, I_XS, I_NF1, I_F1WI, I_F1WO, I_NMIX, I_ABIN, I_POOLW, I_POOLS, I_HCW, I_HCB, I_HW1, I_HB1, I_HW2, I_HB2, I_HW3, I_HB3, I_HW4, I_HB4, I_HFREQ, I_HD,
       I_ABOUT, I_WQKV, I_WO, I_SINK, I_RELB, I_NF2, I_F2WI, I_F2WO, I_NFIN };

struct Mat { const float* src; const float* gain; bf16* dst; int K, N, srcN, swi; };
constexpr int NMAT = 34;
__device__ __forceinline__ Mat get_mat(KArgs a, int mi) {
    Mat m; m.gain = nullptr; m.swi = 0;
    unsigned char* ws = a->ws;
    if (mi < 16) { const int l = mi >> 2, w = mi & 3; unsigned char* fb = ws + WS_W + (size_t)(l * 2 + (w >> 1)) * SZ_FFN;
        if ((w & 1) == 0) { m.src = a->in[(w >> 1) ? I_F2WI : I_F1WI] + (size_t)l * D * 2 * DFF; m.gain = a->in[(w >> 1) ? I_NF2 : I_NF1] + l * D; m.dst = (bf16*)fb; m.K = D; m.N = 2 * DFF; m.srcN = 2 * DFF; m.swi = 1; }
        else { m.src = a->in[(w >> 1) ? I_F2WO : I_F1WO] + (size_t)l * DFF * D; m.dst = (bf16*)(fb + SZ_WI); m.K = DFF; m.N = D; m.srcN = D; }
        return m; }
    mi -= 16;
    if (mi < 10) { const int i = mi / 5, w = mi % 5; unsigned char* mb = ws + WS_WMIX + (size_t)i * SZ_MIX;
        if (w == 0) { m.src = a->in[I_ABIN] + (size_t)i * D * ABIN; m.gain = a->in[I_NMIX] + (2 * i) * D; m.dst = (bf16*)mb; m.K = D; m.N = ABIN; m.srcN = ABIN; }
        else if (w == 1) { m.src = a->in[I_ABOUT] + (size_t)i * D * D; m.dst = (bf16*)(mb + SZ_ABIN); m.K = D; m.N = D; m.srcN = D; }
        else if (w == 2) { m.src = a->in[I_WQKV] + (size_t)i * D * QKV; m.gain = a->in[I_NMIX] + (2 * i + 1) * D; m.dst = (bf16*)(mb + SZ_ABIN + SZ_DD + SZ_POOL); m.K = D; m.N = QKV; m.srcN = QKV; }
        else if (w == 3) { m.src = a->in[I_WO] + (size_t)i * D * D; m.dst = (bf16*)(mb + SZ_ABIN + SZ_DD + SZ_POOL + SZ_QKV); m.K = D; m.N = D; m.srcN = D; }
        else { m.src = a->in[I_POOLW] + (size_t)i * 4 * 65536; m.dst = (bf16*)(mb + SZ_ABIN + SZ_DD); m.K = 256; m.N = 256; m.srcN = 256; }
        return m; }
    mi -= 10;
    { const int i = mi / 3, gq = 1 + mi % 3; unsigned char* mb = ws + WS_WMIX + (size_t)i * SZ_MIX;
      m.src = a->in[I_POOLW] + (size_t)(i * 4 + gq) * 65536; m.dst = (bf16*)(mb + SZ_ABIN + SZ_DD) + (size_t)gq * 65536; m.K = 256; m.N = 256; m.srcN = 256; }
    return m;
}
constexpr int NMAT_USED = 32;

__device__ __forceinline__ void cvt_item(const Mat& mt, int item, int lane) {
    const int nblk = mt.N / 64, kb = item / nblk, nb = item % nblk, k0 = 64 * kb, n0 = 64 * nb;
    int s0 = n0;
    if (mt.swi) { const int pn = n0 >> 8, half = (n0 >> 7) & 1, jj = n0 & 127; s0 = half * DFF + 128 * pn + jj; }
    const int kg = lane >> 4, nq = lane & 15;
    const float* src = mt.src + (size_t)(k0 + 16 * kg) * mt.srcN + s0 + 4 * nq;
    f32x4 v[16];
#pragma unroll
    for (int i = 0; i < 16; ++i) v[i] = *(const f32x4*)(src + (size_t)i * mt.srcN);
    if (mt.gain) { const f32x4* g4 = (const f32x4*)(mt.gain + k0 + 16 * kg);
#pragma unroll
        for (int q = 0; q < 4; ++q) { const f32x4 g = g4[q];
#pragma unroll
            for (int x = 0; x < 4; ++x) v[4 * q + x] = v[4 * q + x] * g[x]; } }
    bf16* dst = mt.dst + (size_t)(n0 + 4 * nq) * mt.K + k0 + 16 * kg;
#pragma unroll
    for (int e = 0; e < 4; ++e)
#pragma unroll
        for (int h = 0; h < 2; ++h) { u32x4 o;
            o.x = cvt_pk_bf16(v[8 * h + 0][e], v[8 * h + 1][e]); o.y = cvt_pk_bf16(v[8 * h + 2][e], v[8 * h + 3][e]);
            o.z = cvt_pk_bf16(v[8 * h + 4][e], v[8 * h + 5][e]); o.w = cvt_pk_bf16(v[8 * h + 6][e], v[8 * h + 7][e]);
            *(u32x4*)(dst + (size_t)e * mt.K + 8 * h) = o; }
}


__device__ __forceinline__ int mat_slot(int mi) {
    return 0;
    if (mi < 16) { const int l = mi >> 2, w = mi & 3; return l == 0 ? 0 : (l == 1 ? 1 : (l == 2 ? (w < 2 ? 0 : 2) : 2)); }
    if (mi < 26) { const int i = (mi - 16) / 5, w = (mi - 16) % 5; if (i == 0) return (w == 2 || w == 3) ? 1 : 0; return w == 0 ? 0 : ((w == 1 || w == 4) ? 1 : 2); }
    return mi < 29 ? 0 : 1;
}
__device__ __forceinline__ void cvt_slot(KArgs ka, int slot, int wv, int nw, int lane) {
    int mi = -1; Mat mt; long base = 0; int cnt = 0;
    for (long it = wv; ; it += nw) {
        while (it >= base + cnt) { base += cnt; cnt = 0; do { ++mi; } while (mi < NMAT_USED && mat_slot(mi) != slot); if (mi >= NMAT_USED) break; mt = get_mat(ka, mi); cnt = (mt.K / 64) * (mt.N / 64); }
        if (mi >= NMAT_USED) break;
        cvt_item(mt, (int)(it - base), lane);
    }
}

__device__ __forceinline__ void filter_job(KArgs a, int jb, LAS float* sm, int tid) {
    const int i = jb / 320, r = jb % 320, lsel = r < 256 ? 0 : 1, tile = lsel ? r - 256 : r, L = lsel ? LS : TP, j0 = tile * 32;
    LAS float* zb = sm; LAS float* ha = sm + 32 * 36; LAS float* hb = ha + 32 * 64;
    const float* w1 = a->in[I_HW1] + i * 33 * 64; const float* b1 = a->in[I_HB1] + i * 64; const float* w2 = a->in[I_HW2] + i * 4096; const float* b2 = a->in[I_HB2] + i * 64;
    const float* w3 = a->in[I_HW3] + i * 4096; const float* b3 = a->in[I_HB3] + i * 64; const float* w4 = a->in[I_HW4] + (size_t)i * 64 * 2048; const float* b4 = a->in[I_HB4] + i * 2048;
    const float* fq = a->in[I_HFREQ] + i * 64;
    const int jj = tid >> 4, og = tid & 15;
    { const int j = j0 + jj; const float wj = 6.283185307179586f * (float)j / (float)L; const float fb = 1e-4f + (float)og * ((15.0f - 1e-4f) / 15.0f); const float ang = fb * wj;
      zb[jj * 36 + 1 + og] = cosf(ang); zb[jj * 36 + 17 + og] = -sinf(ang); if (og == 0) zb[jj * 36] = (float)j / (float)(L - 1); }
    __syncthreads();
    { float acc[4];
#pragma unroll
      for (int q = 0; q < 4; ++q) acc[q] = b1[og * 4 + q];
#pragma unroll 3
      for (int e = 0; e < 33; ++e) { const float z = zb[jj * 36 + e]; const f32x4 w = *(const f32x4*)(w1 + e * 64 + og * 4);
#pragma unroll
          for (int q = 0; q < 4; ++q) acc[q] += z * w[q]; }
#pragma unroll
      for (int q = 0; q < 4; ++q) ha[jj * 64 + og * 4 + q] = sinf(fq[og * 4 + q] * acc[q]); }
    __syncthreads();
    { float acc[4];
#pragma unroll
      for (int q = 0; q < 4; ++q) acc[q] = b2[og * 4 + q];
#pragma unroll 4
      for (int e = 0; e < 64; ++e) { const float z = ha[jj * 64 + e]; const f32x4 w = *(const f32x4*)(w2 + e * 64 + og * 4);
#pragma unroll
          for (int q = 0; q < 4; ++q) acc[q] += z * w[q]; }
#pragma unroll
      for (int q = 0; q < 4; ++q) hb[jj * 64 + og * 4 + q] = sinf(fq[og * 4 + q] * acc[q]); }
    __syncthreads();
    { float acc[4];
#pragma unroll
      for (int q = 0; q < 4; ++q) acc[q] = b3[og * 4 + q];
#pragma unroll 4
      for (int e = 0; e < 64; ++e) { const float z = hb[jj * 64 + e]; const f32x4 w = *(const f32x4*)(w3 + e * 64 + og * 4);
#pragma unroll
          for (int q = 0; q < 4; ++q) acc[q] += z * w[q]; }
#pragma unroll
      for (int q = 0; q < 4; ++q) ha[jj * 64 + og * 4 + q] = sinf(fq[og * 4 + q] * acc[q]); }
    __syncthreads();
    const int c4 = tid * 4, ch = c4 & 1023; const bool isb = c4 >= 1024;
    bf16* KT = (bf16*)(a->ws + WS_KT + (size_t)i * SZ_KT1 + (lsel ? (size_t)2 * TP * 1024 * 2 : 0));
    float* kp = (float*)(a->ws + WS_KPART) + ((size_t)i * 320 + r) * 2048;
    const float dmin = -3.0701134573253945f, dmax = -15.350567286626973f;
    float ad[4];
#pragma unroll
    for (int q = 0; q < 4; ++q) ad[q] = fabsf(dmin + (float)(ch + q) * ((dmax - dmin) / 1023.0f));
    const f32x4 bias = *(const f32x4*)(b4 + c4);
    float asum[4] = {0.f, 0.f, 0.f, 0.f};
    for (int grp = 0; grp < 4; ++grp) {
        float acc[8][4];
#pragma unroll
        for (int q = 0; q < 8; ++q)
#pragma unroll
            for (int x = 0; x < 4; ++x) acc[q][x] = bias[x];
#pragma unroll 8
        for (int k = 0; k < 64; ++k) { const f32x4 w = *(const f32x4*)(w4 + (size_t)k * 2048 + c4);
#pragma unroll
            for (int q = 0; q < 8; ++q) { const float hv = ha[(grp * 8 + q) * 64 + k];
#pragma unroll
                for (int x = 0; x < 4; ++x) acc[q][x] += hv * w[x]; } }
#pragma unroll
        for (int q = 0; q < 8; ++q) { const int j = j0 + grp * 8 + q; const float tj = (float)j / (float)(L - 1); float v[4];
#pragma unroll
            for (int x = 0; x < 4; ++x) v[x] = acc[q][x] * expf(-tj * ad[x]);
            if (!(isb && j == 0)) {
#pragma unroll
                for (int x = 0; x < 4; ++x) asum[x] += fabsf(v[x]);
                const int m = isb ? L - j : L + j;
                u32x2 w; w.x = pk2(v[0], v[1]); w.y = pk2(v[2], v[3]);
                *(u32x2*)(KT + (size_t)m * 1024 + ch) = w; } }
    }
    *(f32x4*)(kp + c4) = (f32x4){asum[0], asum[1], asum[2], asum[3]};
    if (tile == 0 && tid < 256) *(u32x2*)(KT + tid * 4) = (u32x2){0u, 0u};
    __syncthreads();
}


__device__ __forceinline__ void r_transpose_tile(const bf16* KTb, bf16* Rb, int L, int tile, LAS unsigned short* sm, int tid) {
    const int mb = tile >> 4, cb = tile & 15, m0 = mb * 64, c0 = cb * 64;
    { const int mr = tid >> 3, cq = tid & 7; const u32x4 v = *(const u32x4*)(KTb + (size_t)(m0 + mr) * 1024 + c0 + 8 * cq);
      LAS unsigned* d = (LAS unsigned*)(sm + mr * 66 + 8 * cq); d[0] = v.x; d[1] = v.y; d[2] = v.z; d[3] = v.w; }
    __syncthreads();
    { const int cc = tid >> 3, mq = tid & 7; bf16* rrow = Rb + (size_t)(c0 + cc) * 2 * L;
#pragma unroll
      for (int k = 0; k < 8; ++k) { const int mm = mq + 8 * k, m = m0 + mm; const unsigned short val = sm[mm * 66 + cc];
          if (m == 0) rrow[0] = 0; else rrow[2 * L - m] = val; } }
    __syncthreads();
}

template <int RHO> __device__ __forceinline__ bf16x8 shift_frag(const u32x4& c0, const u32x4& c1) {
    const unsigned w[8] = {c0.x, c0.y, c0.z, c0.w, c1.x, c1.y, c1.z, c1.w}; u32x4 o;
    if constexpr ((RHO & 1) == 0) { o.x = w[RHO / 2]; o.y = w[RHO / 2 + 1]; o.z = w[RHO / 2 + 2]; o.w = w[RHO / 2 + 3]; }
    else { constexpr int b = RHO / 2; o.x = __builtin_amdgcn_alignbit(w[b + 1], w[b], 16); o.y = __builtin_amdgcn_alignbit(w[b + 2], w[b + 1], 16);
           o.z = __builtin_amdgcn_alignbit(w[b + 3], w[b + 2], 16); o.w = __builtin_amdgcn_alignbit(w[b + 4], w[b + 3], 16); }
    return __builtin_bit_cast(bf16x8, o);
}

typedef unsigned u32x4a4 __attribute__((ext_vector_type(4), aligned(4)));
template <bool PROMPT, int HALF, int GSEL = -1>
__device__ __forceinline__ void conv_item(unsigned char* ws, KArgs ka, int ib, int oct, int g, LAS unsigned char* lds, int tid, int lane, int wave) {
    constexpr int L = PROMPT ? TP : LS;
    { unsigned ones_ = ~0u; asm volatile("" : "+s"(ones_)); lane = (int)__builtin_amdgcn_mbcnt_hi(ones_, __builtin_amdgcn_mbcnt_lo(ones_, 0u)); }
    const int c = oct * 8 + wave, c0 = oct * 8;
    const bf16* Rc = (const bf16*)(ws + WS_R) + (PROMPT ? (size_t)0 : (size_t)2 * TP * 1024) + (size_t)c * 2 * L + L;
    const int nn = lane & 15, kq = lane >> 4;
    const int xa = 8 * kq - 2 * nn;
    LAS unsigned char* vl = lds + wave * (33 * 528);
    { const bf16* Vg = (const bf16*)(ws + WS_VVT) + (size_t)c * T + (PROMPT ? 0 : TP + 4 * g * LS);
      __syncthreads();
#pragma unroll 4
      for (int it = 0; it < 16; ++it) { const int s_ = (it * 64 + lane) * 8; *(LAS u32x4*)(vl + (s_ >> 8) * 528 + (s_ & 255) * 2) = *(const u32x4*)(Vg + s_); }
      unsigned zz_ = 0u; asm volatile("" : "+v"(zz_));
      if (lane < 33) *(LAS u32x4*)(vl + 32 * 528 + lane * 16) = (u32x4){zz_, zz_, zz_, zz_}; }
    constexpr int NB = PROMPT ? 32 : 8, GS = PROMPT ? 16 : 4;
    const int nbv = PROMPT ? nn : (nn >> 2);
    LAS unsigned char* vcol = vl + 16 * kq + (PROMPT ? 0 : 8 * (nn & 3)) * 528;
    const int zrow = PROMPT ? 32 : 32 - 8 * (nn & 3);
    constexpr int W = (HALF == 2) ? 8 : 4, MO = (HALF == 1) ? 4 : 0;
    f32x4 acc[2][W][2];
#pragma unroll
    for (int r = 0; r < 2; ++r)
#pragma unroll
        for (int q = 0; q < W; ++q)
#pragma unroll
            for (int gg = 0; gg < 2; ++gg) acc[r][q][gg] = (f32x4){0.f, 0.f, 0.f, 0.f};
    constexpr int E0 = PROMPT ? -255 : -63, E1 = PROMPT ? -135 : -39, E2 = PROMPT ? 129 : 33, E3 = PROMPT ? 257 : 65;
    static_assert((E1 - E0) % 8 == 0 && (E2 - E1) % 8 == 0 && (E3 - E2) % 8 == 0, "segments are whole 8-step blocks");
    constexpr int DA = (HALF == 2 && GSEL < 0) ? 2 : 4;
    u32x4 rh[DA]; unsigned rl[DA];
    u32x4 F0[W], F1[W];
#define CONV_LOADA(e_, k_) do { const int xh_ = min(32 * (e_) + xa, L - 8); rh[k_] = *(const u32x4a4*)(Rc + xh_); asm volatile("" ::: "memory"); rl[k_] = *(const unsigned*)(Rc + xh_ - 2); } while (0)
#define CONV_LDF(m_, gsel_, dst_) do { const int rr_ = nbv + (gsel_) * GS + ((m_) >> 3); const int row_ = ((unsigned)rr_ < (unsigned)NB) ? rr_ : zrow; \
        dst_ = *(const LAS u32x4*)(vcol + row_ * 528 + 64 * ((m_) & 7)); } while (0)
#define CONV_MM(r0_, q_, gg_, a_, f_) acc[r0_][q_][gg_] = __builtin_amdgcn_mfma_f32_16x16x32_bf16(a_, __builtin_bit_cast(bf16x8, f_), acc[r0_][q_][gg_], 0, 0, 0)
#define CONV_STEP(j, DO0, DO1) do { const int ee_ = e + (j); \
        const u32x4 ah_ = rh[(j) % DA]; const unsigned al_ = rl[(j) % DA]; \
        CONV_LOADA(ee_ + DA, (j) % DA); \
        asm volatile("" ::: "memory"); \
        u32x4 as_; as_.x = __builtin_amdgcn_alignbit(ah_.x, al_, 16); as_.y = __builtin_amdgcn_alignbit(ah_.y, ah_.x, 16); as_.z = __builtin_amdgcn_alignbit(ah_.z, ah_.y, 16); as_.w = __builtin_amdgcn_alignbit(ah_.w, ah_.z, 16); \
        const bf16x8 a0_ = __builtin_bit_cast(bf16x8, ah_), a1_ = __builtin_bit_cast(bf16x8, as_); \
        __builtin_amdgcn_s_setprio(1); \
        if (DO0) { CONV_MM(0, 0, 0, a0_, F0[(j) % W]); CONV_MM(1, 0, 0, a1_, F0[(j) % W]); } \
        if (DO1) { CONV_MM(0, 0, 1, a0_, F1[(j) % W]); CONV_MM(1, 0, 1, a1_, F1[(j) % W]); } \
        if (DO0) CONV_LDF(ee_ + MO + W, 0, F0[(j) % W]); \
        if (DO1) CONV_LDF(ee_ + MO + W, 1, F1[(j) % W]); \
        _Pragma("unroll") for (int q_ = 1; q_ < W; ++q_) { \
            if (DO0) { CONV_MM(0, q_, 0, a0_, F0[((j) + q_) % W]); CONV_MM(1, q_, 0, a1_, F0[((j) + q_) % W]); } \
            if (DO1) { CONV_MM(0, q_, 1, a0_, F1[((j) + q_) % W]); CONV_MM(1, q_, 1, a1_, F1[((j) + q_) % W]); } } \
        __builtin_amdgcn_s_setprio(0); \
        __builtin_amdgcn_sched_barrier(0); } while (0)
#define CONV_BLOCK(DO0, DO1) do { CONV_STEP(0, DO0, DO1); CONV_STEP(1, DO0, DO1); CONV_STEP(2, DO0, DO1); CONV_STEP(3, DO0, DO1); CONV_STEP(4, DO0, DO1); CONV_STEP(5, DO0, DO1); CONV_STEP(6, DO0, DO1); CONV_STEP(7, DO0, DO1); } while (0)
    if constexpr (GSEL < 0) {
#pragma unroll
    for (int k = 0; k < DA; ++k) CONV_LOADA(E0 + k, k);
    { unsigned zz_ = 0u; asm volatile("" : "+v"(zz_));
#pragma unroll
      for (int k = 0; k < W; ++k) F1[k] = (u32x4){zz_, zz_, zz_, zz_}; }
    for (int e = E0; e < E1; e += 8) CONV_BLOCK(false, true);
    { unsigned zz_ = 0u; asm volatile("" : "+v"(zz_));
#pragma unroll
      for (int k = 0; k < W; ++k) F0[k] = (u32x4){zz_, zz_, zz_, zz_}; }
    for (int e = E1; e < E2; e += 8) CONV_BLOCK(true, true);
    for (int e = E2; e < E3; e += 8) CONV_BLOCK(true, false);
    } else if constexpr (GSEL == 0) {
#pragma unroll
    for (int k = 0; k < DA; ++k) CONV_LOADA(E1 + k, k);
    { unsigned zz_ = 0u; asm volatile("" : "+v"(zz_));
#pragma unroll
      for (int k = 0; k < W; ++k) F0[k] = (u32x4){zz_, zz_, zz_, zz_}; }
    for (int e = E1; e < E3; e += 8) CONV_BLOCK(true, false);
    } else {
#pragma unroll
    for (int k = 0; k < DA; ++k) CONV_LOADA(E0 + k, k);
    { unsigned zz_ = 0u; asm volatile("" : "+v"(zz_));
#pragma unroll
      for (int k = 0; k < W; ++k) F1[k] = (u32x4){zz_, zz_, zz_, zz_}; }
    for (int e = E0; e < E2; e += 8) CONV_BLOCK(false, true);
    }
#undef CONV_BLOCK
#undef CONV_STEP
#undef CONV_MM
#undef CONV_LDF
#undef CONV_LOADA
    __syncthreads();
    int lane2; { unsigned ones_ = ~0u; asm volatile("" : "+s"(ones_)); lane2 = (int)__builtin_amdgcn_mbcnt_hi(ones_, __builtin_amdgcn_mbcnt_lo(ones_, 0u)); }
    const int nn2 = lane2 & 15, kq2 = lane2 >> 4;
    float nsum = 0.f;
    { const float* kq_ = (const float*)(ws + WS_KPART) + ((size_t)ib * 320 + (PROMPT ? 0 : 256)) * 2048; constexpr int ntile = PROMPT ? 256 : 64;
      for (int q = lane2; q < ntile; q += 64) nsum += kq_[(size_t)q * 2048 + c] + kq_[(size_t)q * 2048 + 1024 + c];
      nsum = wave_sum(nsum); }
    const float inv = 1.0f / nsum;
    LAS float* stage = (LAS float*)lds;
    const int tid2 = wave * 64 + lane2;
    const float* dbias = ka->in[I_HD] + ib * 1024 + c0;
    const bf16* X0B = (const bf16*)(ws + WS_X0); const bf16* VVB = (const bf16*)(ws + WS_VV); bf16* AMIX = (bf16*)(ws + WS_AMIX);
    if constexpr (GSEL >= 0) {
        static_assert(PROMPT && HALF == 2, "group-half items are prompt items with all eight rho1");
        u32x4 xv8[8], vv8[8];
#pragma unroll
        for (int k = 0; k < 8; ++k) { const int row = tid2 + 512 * k, n = 16 * GSEL + (row & 15), tl = row >> 4; const int t = 256 * n + tl;
            xv8[k] = *(const u32x4*)(X0B + (size_t)t * 1024 + c0); vv8[k] = *(const u32x4*)(VVB + (size_t)t * 1024 + c0); }
#pragma unroll
        for (int q1 = 0; q1 < 8; ++q1)
#pragma unroll
            for (int r0 = 0; r0 < 2; ++r0)
#pragma unroll
                for (int j = 0; j < 4; ++j) { const int tl = 32 * q1 + 2 * (4 * kq2 + j) + r0; stage[wave * 4096 + tl * 16 + nn2] = acc[r0][q1][GSEL][j] * inv; }
        __syncthreads();
        float db[8];
#pragma unroll
        for (int q = 0; q < 8; ++q) db[q] = dbias[q];
#pragma unroll
        for (int k = 0; k < 8; ++k) { const int row = tid2 + 512 * k, n = 16 * GSEL + (row & 15), tl = row >> 4; const int t = 256 * n + tl;
            float y[8];
#pragma unroll
            for (int q = 0; q < 8; ++q) y[q] = stage[q * 4096 + row];
            const u32x4 xv = xv8[k], vv = vv8[k];
            u32x4 o;
            o.x = pk2((y[0] + bflo(vv.x) * db[0]) * bflo(xv.x), (y[1] + bfhi(vv.x) * db[1]) * bfhi(xv.x));
            o.y = pk2((y[2] + bflo(vv.y) * db[2]) * bflo(xv.y), (y[3] + bfhi(vv.y) * db[3]) * bfhi(xv.y));
            o.z = pk2((y[4] + bflo(vv.z) * db[4]) * bflo(xv.z), (y[5] + bfhi(vv.z) * db[5]) * bfhi(xv.z));
            o.w = pk2((y[6] + bflo(vv.w) * db[6]) * bflo(xv.w), (y[7] + bfhi(vv.w) * db[7]) * bfhi(xv.w));
            *(u32x4*)(AMIX + (size_t)t * D + 1024 + c0) = o; }
        __syncthreads();
    } else
#pragma unroll
    for (int h = 0; h < 2; ++h) {
        if (HALF != 2 && h != HALF) continue;
#pragma unroll
        for (int rp = 0; rp < 4; ++rp)
#pragma unroll
            for (int r0 = 0; r0 < 2; ++r0)
#pragma unroll
                for (int gg = 0; gg < 2; ++gg)
#pragma unroll
                    for (int j = 0; j < 4; ++j) { const int tl = 32 * rp + 2 * (4 * kq2 + j) + r0; stage[wave * 4096 + tl * 32 + 16 * gg + nn2] = acc[r0][(HALF == 2 ? 4 * h : 0) + rp][gg][j] * inv; }
        __syncthreads();
        float db[8];
#pragma unroll
        for (int q = 0; q < 8; ++q) db[q] = dbias[q];
#pragma unroll 2
        for (int k = 0; k < 8; ++k) { const int row = tid2 + 512 * k, n = row & 31, tl = row >> 5;
            int t; if (PROMPT) t = 256 * n + 128 * h + tl; else t = TP + (4 * g + (n & 3)) * LS + 256 * (n >> 2) + 128 * h + tl;
            float y[8];
#pragma unroll
            for (int q = 0; q < 8; ++q) y[q] = stage[q * 4096 + row];
            const u32x4 xv = *(const u32x4*)(X0B + (size_t)t * 1024 + c0), vv = *(const u32x4*)(VVB + (size_t)t * 1024 + c0);
            u32x4 o;
            o.x = pk2((y[0] + bflo(vv.x) * db[0]) * bflo(xv.x), (y[1] + bfhi(vv.x) * db[1]) * bfhi(xv.x));
            o.y = pk2((y[2] + bflo(vv.y) * db[2]) * bflo(xv.y), (y[3] + bfhi(vv.y) * db[3]) * bfhi(xv.y));
            o.z = pk2((y[4] + bflo(vv.z) * db[4]) * bflo(xv.z), (y[5] + bfhi(vv.z) * db[5]) * bfhi(xv.z));
            o.w = pk2((y[6] + bflo(vv.w) * db[6]) * bflo(xv.w), (y[7] + bfhi(vv.w) * db[7]) * bfhi(xv.w));
            *(u32x4*)(AMIX + (size_t)t * D + 1024 + c0) = o; }
        __syncthreads();
    }
}

__device__ __forceinline__ void seq_of(int t, int& s0, int& L) { if (t < TP) { s0 = 0; L = TP; } else { s0 = TP + ((t - TP) / LS) * LS; L = LS; } }

__global__ void __launch_bounds__(512, 2) fwd_kernel(Args args) {
    extern __shared__ __attribute__((aligned(16))) unsigned char lds_raw[];
    LAS unsigned char* lds = (LAS unsigned char*)lds_raw;
    const int tid0 = threadIdx.x; const int wave0 = __builtin_amdgcn_readfirstlane(tid0 >> 6);
    const int G = gridDim.x, NGW = G * 8;
#define PHASE_IDS unsigned ones_ = ~0u; asm volatile("" : "+s"(ones_)); const int lane = (int)__builtin_amdgcn_mbcnt_hi(ones_, __builtin_amdgcn_mbcnt_lo(ones_, 0u)); const int wave = wave0, tid = wave * 64 + lane, gw = blockIdx.x * 8 + wave; (void)tid; (void)lane; (void)gw; KArgs ka = (KArgs)__builtin_amdgcn_kernarg_segment_ptr(); asm volatile("" : "+s"(ka)); unsigned char* const ws = ka->ws; (void)ws; \
    bf16* const XB = (bf16*)(ws + WS_XB); bf16* const HB = (bf16*)(ws + WS_H); bf16* const AMIX = (bf16*)(ws + WS_AMIX); bf16* const PB = (bf16*)(ws + WS_P); bf16* const X0B = (bf16*)(ws + WS_X0); bf16* const VVB = (bf16*)(ws + WS_VV); \
    float* const PART = (float*)(ws + WS_PART); float* const OUT = ka->out; (void)XB; (void)HB; (void)AMIX; (void)PB; (void)X0B; (void)VVB; (void)PART; (void)OUT;
    unsigned char* ws0 = args.ws;
    volatile LAS unsigned* MISC = (volatile LAS unsigned*)(lds + MISC_OFF);
    if (tid0 < 64) MISC[tid0] = 0u;
    __syncthreads();
    XcdBarrier bar; bar.bar = (unsigned*)(ws0 + WS_CTL) + 4096; bar.x = 0; bar.st = MISC + 8;
#if !MK_PER_PHASE
    bar = xcd_barrier_post((unsigned*)(ws0 + WS_CTL) + 4096, MISC + 8);
#endif
    const int lo = args.ph_lo, hi = args.ph_hi;
#define RUN(k) (lo <= (k) && (k) < hi)
#if MK_PER_PHASE
#define SEAM(k) do { } while (0)
#else
#define SEAM(k) do { if (RUN(k) && RUN((k) + 1)) xcd_barrier(bar); } while (0)
#endif
    int ph = 0;

    if (RUN(ph)) { PHASE_IDS
        for (int step = 0; step < 2; ++step) {
            if ((step == 0) != ((blockIdx.x & 1) != 0)) {
                for (int jb = blockIdx.x; jb < 640; jb += G) filter_job(ka, jb, (LAS float*)lds, tid);
            } else {
        for (int m = gw; m < T; m += NGW) {
            const float* xr = (m < TP) ? ka->in[I_XP] + (size_t)m * D : ka->in[I_XS] + (size_t)(m - TP) * D;
            const f32x4* x4 = (const f32x4*)xr + lane; float ss = 0.f; u32x2* o = (u32x2*)(XB + (size_t)m * D) + lane;
#pragma unroll
            for (int j = 0; j < 8; ++j) { const f32x4 v = x4[64 * j]; ss += (v[0] * v[0] + v[1] * v[1]) + (v[2] * v[2] + v[3] * v[3]); o[64 * j] = (u32x2){pk2(v[0], v[1]), pk2(v[2], v[3])}; }
            ss = wave_sum(ss);
            if (lane < 32) PART[(size_t)m * 32 + lane] = lane == 0 ? ss : 0.f;
        }
        cvt_slot(ka, 0, gw, NGW, lane);
            }
        }
    }
    SEAM(ph); ++ph;

    for (int l = 0; l < 4; ++l) {
        const int ib = l >> 1;
        for (int f = 0; f < 3; ++f) {
            if (f != 1) {
                if (RUN(ph)) { PHASE_IDS
                    unsigned char* fw = ws + WS_W + (size_t)(l * 2 + (f >> 1)) * SZ_FFN; pg8::Gemm g{XB, (const bf16*)fw, T, 2 * DFF, D, D, D, 0}; pg8::StaticOrder S; S.init(T, 2 * DFF, G, (int)blockIdx.x);
                    pg8::EpiSwiGLU E{HB, PART};
                    pg8::gemm_phase<pg8::EpiSwiGLU, true>(lds, g, S, E, tid);
                }
                SEAM(ph); ++ph;
                if (RUN(ph)) { PHASE_IDS
                    unsigned char* fw = ws + WS_W + (size_t)(l * 2 + (f >> 1)) * SZ_FFN; pg8::Gemm g{HB, (const bf16*)(fw + SZ_WI), T, D, DFF, DFF, DFF, 0}; pg8::StaticOrder S; S.init(T, D, G, (int)blockIdx.x, 1);
                    pg8::EpiResid E{XB, PART, 0.5f};
                    pg8::gemm_phase<pg8::EpiResid, true>(lds, g, S, E, tid);
                }
                SEAM(ph); ++ph;
            } else {
                const bool even = (l & 1) == 0;
                if (RUN(ph)) { PHASE_IDS
                    const int N = even ? ABIN : QKV; unsigned char* mixw = ws + WS_WMIX + (size_t)ib * SZ_MIX;
                    pg8::Gemm g{XB, (const bf16*)(even ? mixw : mixw + SZ_ABIN + SZ_DD + SZ_POOL), T, N, D, D, D, 0}; pg8::StaticOrder S; S.init(T, N, G, (int)blockIdx.x);
                    pg8::EpiScale E{HB, N, PART};
                    pg8::gemm_phase<pg8::EpiScale, true>(lds, g, S, E, tid);
                }
                SEAM(ph); ++ph;
                if (even) {
                    if (RUN(ph)) { PHASE_IDS
                        { const bf16* KT0 = (const bf16*)(ws + WS_KT + (size_t)ib * SZ_KT1); bf16* R0 = (bf16*)(ws + WS_R);
                          for (int tile = blockIdx.x; tile < 5120; tile += G) {
                              if (tile < 4096) r_transpose_tile(KT0, R0, TP, tile, (LAS unsigned short*)lds, tid);
                              else r_transpose_tile(KT0 + (size_t)2 * TP * 1024, R0 + (size_t)2 * TP * 1024, LS, tile - 4096, (LAS unsigned short*)lds, tid); } }
                        const float* cw = ka->in[I_HCW] + (size_t)ib * 3 * 3072; const float* cb = ka->in[I_HCB] + (size_t)ib * 3072;
                        bf16* VVT = (bf16*)(ws + WS_VVT);
                        LAS unsigned* vvl = (LAS unsigned*)lds;
                        for (int tile = blockIdx.x; tile < T / 32; tile += G) {
                          const int tok0 = tile * 32; int s0, L; seq_of(tok0, s0, L);
                          {
                            const int gq = wave & 3, th = wave >> 2, ck = gq * 32 + (lane & 31), c = ck * 8, tlocA = 16 * th + 8 * (lane >> 5), tA = tok0 + tlocA, tlA = tA - s0;
                            const u32x4 z = (u32x4){0u, 0u, 0u, 0u};
                            { const int hw = 1 << gq; float S[8] = {0, 0, 0, 0, 0, 0, 0, 0};
                              const bf16* ua = HB + (size_t)s0 * ABIN + c;
#define PREP_ROW(r) (((r) >= 0 && (r) < L) ? *(const u32x4*)(ua + (size_t)(r) * ABIN) : z)
#define PREP_ACC(S, v, sg) do { S[0] += sg bflo(v.x); S[1] += sg bfhi(v.x); S[2] += sg bflo(v.y); S[3] += sg bfhi(v.y); S[4] += sg bflo(v.z); S[5] += sg bfhi(v.z); S[6] += sg bflo(v.w); S[7] += sg bfhi(v.w); } while (0)
                              u32x4 vc[8], vin[7], vout[7];
#pragma unroll
                              for (int j = 0; j < 8; ++j) vc[j] = *(const u32x4*)(ua + (size_t)(tlA + j) * ABIN);
#pragma unroll
                              for (int j = 0; j < 7; ++j) { vin[j] = PREP_ROW(tlA + j + hw); vout[j] = PREP_ROW(tlA + j - hw); }
                              for (int q = 0; q < 2 * hw; ++q) { const u32x4 v = PREP_ROW(tlA - hw + q); PREP_ACC(S, v, +); }
#pragma unroll
                              for (int j = 0; j < 8; ++j) { const int tl = tlA + j; const int lo_ = max(tl - hw, 0), hi_ = min(tl + hw, L); const float inv = 1.0f / (float)(hi_ - lo_);
                                  const u32x4 v = vc[j];
                                  u32x4 o; o.x = pk2(S[0] * inv - bflo(v.x), S[1] * inv - bfhi(v.x)); o.y = pk2(S[2] * inv - bflo(v.y), S[3] * inv - bfhi(v.y));
                                  o.z = pk2(S[4] * inv - bflo(v.z), S[5] * inv - bfhi(v.z)); o.w = pk2(S[6] * inv - bflo(v.w), S[7] * inv - bfhi(v.w));
                                  *(u32x4*)(PB + (size_t)(s0 + tl) * 1024 + c) = o;
                                  if (j < 7) { const u32x4 va = vin[j], vs_ = vout[j]; PREP_ACC(S, va, +); PREP_ACC(S, vs_, -); } }
#undef PREP_ACC
#undef PREP_ROW
                            }
                            float x1k[8][8];
#pragma unroll
                            for (int comp = 0; comp < 3; ++comp) { const int cc = comp * 1024 + c; const bf16* ub = HB + (size_t)s0 * ABIN + 1024 + cc;
                                float w0[8], w1[8], w2[8], bb[8];
#pragma unroll
                                for (int e = 0; e < 8; e += 4) { const f32x4 a0 = *(const f32x4*)(cw + cc + e), a1 = *(const f32x4*)(cw + 3072 + cc + e), a2 = *(const f32x4*)(cw + 6144 + cc + e), a3 = *(const f32x4*)(cb + cc + e);
#pragma unroll
                                    for (int x = 0; x < 4; ++x) { w0[e + x] = a0[x]; w1[e + x] = a1[x]; w2[e + x] = a2[x]; bb[e + x] = a3[x]; } }
                                u32x4 rows[10];
#pragma unroll
                                for (int q = 0; q < 10; ++q) { const int r = tlA - 1 + q; rows[q] = (r >= 0 && r < L) ? *(const u32x4*)(ub + (size_t)r * ABIN) : z; }
#pragma unroll
                                for (int j = 0; j < 8; ++j) { float uc[8];
                                    const unsigned am[4] = {rows[j].x, rows[j].y, rows[j].z, rows[j].w}, a0[4] = {rows[j + 1].x, rows[j + 1].y, rows[j + 1].z, rows[j + 1].w}, ap[4] = {rows[j + 2].x, rows[j + 2].y, rows[j + 2].z, rows[j + 2].w};
#pragma unroll
                                    for (int e = 0; e < 8; ++e) { const float xm = (e & 1) ? bfhi(am[e >> 1]) : bflo(am[e >> 1]), x0 = (e & 1) ? bfhi(a0[e >> 1]) : bflo(a0[e >> 1]), xp = (e & 1) ? bfhi(ap[e >> 1]) : bflo(ap[e >> 1]);
                                        uc[e] = xm * w0[e] + x0 * w1[e] + xp * w2[e] + bb[e]; }
                                    const size_t orow = (size_t)(tA + j) * 1024 + c;
                                    if (comp == 0) { u32x4 o; o.x = pk2(uc[0], uc[1]); o.y = pk2(uc[2], uc[3]); o.z = pk2(uc[4], uc[5]); o.w = pk2(uc[6], uc[7]); *(u32x4*)(X0B + orow) = o; }
                                    else if (comp == 1) {
#pragma unroll
                                        for (int e = 0; e < 8; ++e) x1k[j][e] = uc[e]; }
                                    else { u32x4 o; o.x = pk2(uc[0] * x1k[j][0], uc[1] * x1k[j][1]); o.y = pk2(uc[2] * x1k[j][2], uc[3] * x1k[j][3]); o.z = pk2(uc[4] * x1k[j][4], uc[5] * x1k[j][5]); o.w = pk2(uc[6] * x1k[j][6], uc[7] * x1k[j][7]);
                                        *(u32x4*)(VVB + orow) = o; LAS unsigned* dl = vvl + (tlocA + j) * 513 + ck * 4; dl[0] = o.x; dl[1] = o.y; dl[2] = o.z; dl[3] = o.w; } } }
                          }
                          __syncthreads();
                          { int l2_ = lane; asm volatile("" : "+v"(l2_)); const LAS unsigned short* vs = (const LAS unsigned short*)vvl; const int tt = l2_ & 31, cp = l2_ >> 5;
                            for (int k = 0; k < 64; ++k) { const int c = 2 * (wave * 64 + k) + cp; VVT[(size_t)c * T + tok0 + tt] = vs[tt * 1026 + c]; } }
                          __syncthreads();
                        }
                    }
                    SEAM(ph); ++ph;
                    if (RUN(ph)) {
                        { PHASE_IDS
                        { unsigned char* mixw = ws + WS_WMIX + (size_t)ib * SZ_MIX; pg8::Gemm g{PB, (const bf16*)(mixw + SZ_ABIN + SZ_DD), T, 1024, 256, 1024, 256, 512}; pg8::StaticOrder S; S.init(T, 1024, G, (int)blockIdx.x);
                          pg8::EpiColScale E{AMIX, D, ka->in[I_POOLS] + ib * 1024};
                          pg8::gemm_phase<pg8::EpiColScale, true>(lds, g, S, E, tid); }
                        }
                        { PHASE_IDS
                        for (int it = (int)blockIdx.x; it < 512; it += G) {
                            if (it < 256) { if (it & 1) conv_item<true, 2, 1>(ws, ka, ib, it >> 1, 0, lds, tid, lane, wave); else conv_item<true, 2, 0>(ws, ka, ib, it >> 1, 0, lds, tid, lane, wave); }
                            else conv_item<false, 2>(ws, ka, ib, (it - 256) >> 1, (it - 256) & 1, lds, tid, lane, wave); }
                        }
                    }
                    SEAM(ph); ++ph;
                } else {
                    if (RUN(ph)) { PHASE_IDS
                        int tab_key = -1;
                        for (int u = blockIdx.x; u < 1536; u += G) att::attn_unit(HB, AMIX, ka->in[I_SINK] + ib * 16, ka->in[I_RELB], u, lds, tid, lane, wave, tab_key);
                    }
                    SEAM(ph); ++ph;
                }
                if (RUN(ph)) { PHASE_IDS
                    unsigned char* mixw = ws + WS_WMIX + (size_t)ib * SZ_MIX; pg8::Gemm g{AMIX, (const bf16*)(even ? mixw + SZ_ABIN : mixw + SZ_ABIN + SZ_DD + SZ_POOL + SZ_QKV), T, D, D, D, D, 0}; pg8::StaticOrder S; S.init(T, D, G, (int)blockIdx.x, 1);
                    pg8::EpiResid E{XB, PART, 1.0f};
                    pg8::gemm_phase<pg8::EpiResid, true>(lds, g, S, E, tid);
                }
                SEAM(ph); ++ph;
            }
        }
    }
    if (RUN(ph)) { PHASE_IDS
        const float* gn = ka->in[I_NFIN];
        for (int m = gw; m < T; m += NGW) {
            float s = lane < 32 ? PART[(size_t)m * 32 + lane] : 0.f; s = wave_sum(s); const float rs = 1.0f / sqrtf(s * (1.0f / D) + EPS);
            f32x4* x4 = (f32x4*)(OUT + (size_t)m * D) + lane; const f32x4* g4 = (const f32x4*)gn + lane; const u32x2* xb2 = (const u32x2*)(XB + (size_t)m * D) + lane;
#pragma unroll
            for (int j = 0; j < 8; ++j) { const u32x2 xw = xb2[64 * j]; const f32x4 v = (f32x4){bflo(xw.x), bfhi(xw.x), bflo(xw.y), bfhi(xw.y)}, gg = g4[64 * j]; x4[64 * j] = v * rs * gg; }
        }
    }
#undef RUN
#undef SEAM
}

extern "C" void kernel_launch(void* const* d_in, const int* in_sizes, int n_in, void* d_out, int out_size, void* d_ws, size_t ws_size, hipStream_t stream) {
    static int grid = 0;
    if (grid == 0) {
        if (n_in != 30 || out_size != T * D || ws_size < WS_END) { fprintf(stderr, "kernel_launch: unexpected shapes (n_in %d, out %d, ws %zu < %zu)\n", n_in, out_size, ws_size, (size_t)WS_END); grid = -1; return; }
        int dev = 0, cus = 0, per_cu = 0;
        if (hipGetDevice(&dev) != hipSuccess || hipDeviceGetAttribute(&cus, hipDeviceAttributeMultiprocessorCount, dev) != hipSuccess) { grid = -1; return; }
        if (hipFuncSetAttribute((const void*)fwd_kernel, hipFuncAttributeMaxDynamicSharedMemorySize, LDS_BYTES) != hipSuccess) { fprintf(stderr, "kernel_launch: hipFuncSetAttribute failed\n"); grid = -1; return; }
        if (hipOccupancyMaxActiveBlocksPerMultiprocessor(&per_cu, (const void*)fwd_kernel, 512, LDS_BYTES) != hipSuccess || per_cu < 1) { fprintf(stderr, "kernel_launch: occupancy query reports %d\n", per_cu); }
        (void)hipGetLastError();
        grid = cus;
    }
    if (grid < 0) return;
    (void)hipMemsetAsync((char*)d_ws + WS_CTL, 0, CTL_BYTES, stream);
    Args a{};
    for (int i = 0; i < 30; ++i) a.in[i] = (const float*)d_in[i];
    a.out = (float*)d_out; a.ws = (unsigned char*)d_ws;
#if MK_PER_PHASE
    for (int p = 0; p < NPHASES; ++p) { a.ph_lo = p; a.ph_hi = p + 1; hipLaunchKernelGGL(fwd_kernel, dim3(grid), dim3(512), LDS_BYTES, stream, a); }
#else
    a.ph_lo = 0; a.ph_hi = NPHASES;
    hipLaunchKernelGGL(fwd_kernel, dim3(grid), dim3(512), LDS_BYTES, stream, a);
#endif
}
```

```cpp
#include <hip/hip_runtime.h>
#include <cstdio>
#include <cstdint>

#ifndef MK_PER_PHASE
#define MK_PER_PHASE 0
#endif

#define LAS __attribute__((address_space(3)))
#define GAS __attribute__((address_space(1)))
typedef unsigned short bf16;
typedef short bf16x8 __attribute__((ext_vector_type(8)));
typedef float f32x4 __attribute__((ext_vector_type(4)));
typedef float f32x2 __attribute__((ext_vector_type(2)));
typedef unsigned u32x4 __attribute__((ext_vector_type(4)));
typedef unsigned u32x2 __attribute__((ext_vector_type(2)));
typedef float f32x16 __attribute__((ext_vector_type(16)));

constexpr int D = 2048, DFF = 5632, T = 24576, TP = 8192, LS = 2048, NSEQ_S = 8;
constexpr int NH = 16, NKV = 4, HD = 128, QKV = 3072, ABIN = 4096, PW = 1024, HW = 1024;
constexpr float EPS = 1e-6f;
constexpr int NPHASES = 32;

constexpr size_t SZ_WI = (size_t)2 * DFF * D * 2, SZ_WO = (size_t)D * DFF * 2;
constexpr size_t SZ_FFN = SZ_WI + SZ_WO;
constexpr size_t SZ_ABIN = (size_t)ABIN * D * 2, SZ_DD = (size_t)D * D * 2, SZ_POOL = (size_t)1024 * 256 * 2, SZ_QKV = (size_t)QKV * D * 2;
constexpr size_t SZ_MIX = SZ_ABIN + SZ_DD + SZ_POOL + SZ_QKV + SZ_DD;
constexpr size_t WS_CTL = 0, CTL_BYTES = 1u << 20;
constexpr size_t WS_W = CTL_BYTES;
constexpr size_t WS_WMIX = WS_W + 8 * SZ_FFN;
constexpr size_t WS_XB = WS_WMIX + 2 * SZ_MIX;
constexpr size_t WS_H = WS_XB + (size_t)T * D * 2;
constexpr size_t WS_AMIX = WS_H + (size_t)T * DFF * 2;
constexpr size_t WS_P = WS_AMIX + (size_t)T * D * 2;
constexpr size_t WS_X0 = WS_P + (size_t)T * 1024 * 2;
constexpr size_t WS_VV = WS_X0 + (size_t)T * 1024 * 2;
constexpr size_t SZ_KT1 = (size_t)(2 * TP + 2 * LS) * 1024 * 2;
constexpr size_t WS_KT = WS_VV + (size_t)T * 1024 * 2;
constexpr size_t WS_PART = WS_KT + 2 * SZ_KT1;
constexpr size_t WS_KPART = WS_PART + (size_t)T * 32 * 4;
constexpr size_t WS_R = WS_KPART + (size_t)2 * 320 * 2048 * 4;
constexpr size_t WS_END = WS_R + (size_t)(2 * TP + 2 * LS) * 1024 * 2;
constexpr size_t WS_VVT = WS_H + (size_t)T * ABIN * 2;
static_assert(WS_VVT + (size_t)T * 1024 * 2 <= WS_AMIX, "VVT must fit behind U in the H region");
static_assert(WS_END <= 1476395008ull, "workspace map exceeds 4x largest input");

constexpr int RING_BYTES = 131072, LDS_BYTES = 147456, MISC_OFF = LDS_BYTES - 256;

#define LDS_WAIT() asm volatile("s_waitcnt lgkmcnt(0)" ::: "memory")
#define VM_WAIT() asm volatile("s_waitcnt vmcnt(0)" ::: "memory")
__device__ __forceinline__ unsigned f2bf(float f) { unsigned u = __builtin_bit_cast(unsigned, f); return (u + 0x7fffu + ((u >> 16) & 1u)) >> 16; }
__device__ __forceinline__ unsigned pk2(float lo, float hi) { return f2bf(lo) | (f2bf(hi) << 16); }
__device__ __forceinline__ unsigned cvt_pk_bf16(float lo, float hi) { unsigned r; asm volatile("v_cvt_pk_bf16_f32 %0, %1, %2" : "=v"(r) : "v"(lo), "v"(hi)); return r; }
__device__ __forceinline__ float bflo(unsigned w) { return __builtin_bit_cast(float, w << 16); }
__device__ __forceinline__ float bfhi(unsigned w) { return __builtin_bit_cast(float, w & 0xffff0000u); }
__device__ __forceinline__ float bf1(bf16 b) { return __builtin_bit_cast(float, (unsigned)b << 16); }
__device__ __forceinline__ float wave_sum(float v) {
#pragma unroll
    for (int o = 1; o < 64; o <<= 1) v += __shfl_xor(v, o);
    return v;
}
__device__ __forceinline__ float wave_max(float v) {
#pragma unroll
    for (int o = 1; o < 64; o <<= 1) v = fmaxf(v, __shfl_xor(v, o));
    return v;
}

#define XB_TMO      128
#define XB_XCNT(j)  (256  + 64 * (j))
#define XB_XSUB(j)  (1280 + 64 * (j))
#define XB_XGEN(j)  (2304 + 64 * (j))
#define XB_TOP      3328
#define XB_TOPGEN   3392
#define XCD_BAR_WORDS 3456
#define XB_SPIN_CAP (1u << 18)
__device__ __forceinline__ unsigned xb_ld(unsigned* p)              { return __hip_atomic_load(p, __ATOMIC_RELAXED, __HIP_MEMORY_SCOPE_AGENT); }
__device__ __forceinline__ unsigned xb_add(unsigned* p, unsigned v) { return __hip_atomic_fetch_add(p, v, __ATOMIC_RELAXED, __HIP_MEMORY_SCOPE_AGENT); }
__device__ __forceinline__ unsigned xb_xcc_id() { return (unsigned)__builtin_amdgcn_s_getreg((3 << 11) | 20) & 0xFu; }
#define XB_SPIN(cond, bar) do { unsigned _sp = 0; while (cond) { __builtin_amdgcn_s_sleep(1); \
    if ((++_sp & 255u) == 0u) { if (xb_ld(&(bar)[XB_TMO])) break; if (_sp > XB_SPIN_CAP) { atomicAdd(&(bar)[XB_TMO], 1u); break; } } } } while (0)
struct XcdBarrier { unsigned* bar; unsigned x; volatile LAS unsigned* st; };
__device__ __forceinline__ XcdBarrier xcd_barrier_post(unsigned* bar, volatile LAS unsigned* st) {
    XcdBarrier b; b.bar = bar; b.x = xb_xcc_id(); b.st = st;
    if (threadIdx.x == 0) (void)xb_add(&bar[XB_XCNT(b.x)], 1u);
    return b;
}
__device__ __forceinline__ void xcd_barrier_complete(unsigned* bar, unsigned x, unsigned& nloc, unsigned& nx) {
    const unsigned G = gridDim.x * gridDim.y * gridDim.z;
    unsigned sum, cnt, mine, sp = 0u;
    for (;;) {
        sum = 0u; cnt = 0u; mine = 0u;
#pragma unroll
        for (unsigned j = 0; j < 16; ++j) { const unsigned c = xb_ld(&bar[XB_XCNT(j)]); sum += c; cnt += (c > 0u) ? 1u : 0u; mine = (j == x) ? c : mine; }
        if (sum == G) break;
        __builtin_amdgcn_s_sleep(1);
        if ((++sp & 255u) == 0u) { if (xb_ld(&bar[XB_TMO])) break; if (sp > XB_SPIN_CAP) { atomicAdd(&bar[XB_TMO], 1u); break; } }
    }
    nloc = mine > 0u ? mine : 1u; nx = cnt > 0u ? cnt : 1u;
}
__device__ __forceinline__ void xcd_barrier(const XcdBarrier& b) {
    asm volatile("s_waitcnt vmcnt(0)" ::: "memory");
    __syncthreads();
    if (threadIdx.x == 0) {
        unsigned* bar = b.bar;
        __builtin_amdgcn_s_waitcnt(0);
        unsigned nloc = b.st[0], nx = b.st[1];
        if (nloc == 0u) { xcd_barrier_complete(bar, b.x, nloc, nx); b.st[0] = nloc; b.st[1] = nx; }
        const unsigned old = xb_add(&bar[XB_XSUB(b.x)], 1u);
        const unsigned gen = old / nloc;
        if (old + 1u == (gen + 1u) * nloc) {
            __builtin_amdgcn_fence(__ATOMIC_RELEASE, "agent");
            asm volatile("s_waitcnt vmcnt(0)" ::: "memory");
            const unsigned og = xb_add(&bar[XB_TOP], 1u);
            const unsigned tg = og / nx;
            if (og + 1u == (tg + 1u) * nx) xb_add(&bar[XB_TOPGEN], 1u);
            else XB_SPIN(xb_ld(&bar[XB_TOPGEN]) == tg, bar);
            __builtin_amdgcn_fence(__ATOMIC_ACQUIRE, "agent");
            xb_add(&bar[XB_XGEN(b.x)], 1u);
            asm volatile("s_waitcnt vmcnt(0)" ::: "memory");
        } else {
            XB_SPIN(xb_ld(&bar[XB_XGEN(b.x)]) == gen, bar);
            __builtin_amdgcn_fence(__ATOMIC_ACQUIRE, "agent");
            asm volatile("s_waitcnt vmcnt(0)" ::: "memory");
        }
    }
    __syncthreads();
}

namespace pg8 {
constexpr int BM = 256, BK = 64, HALF = 128, HTB = HALF * BK * 2, STAGE_BYTES = 8 * HTB, NXCD = 8, WGM = 8;
__host__ __device__ __forceinline__ int lds_byte(int r, int c) { const int st = (r >> 4) * 2 + (c >> 5), rr = r & 15, cc = c & 31, ob = rr * 64 + cc * 2; return st * 1024 + (ob ^ (((ob >> 9) & 1) << 5)); }
__host__ __device__ __forceinline__ void stage_rc(int b, int& R, int& C) { const int st = b / 1024, sb = b % 1024, swz = sb ^ (((sb >> 9) & 1) << 5); R = (st >> 1) * 16 + swz / 64; C = (st & 1) * 32 + (swz % 64) / 2; }
__host__ __device__ __forceinline__ int perm32(int rho) { const int n = rho >> 4, i = rho & 15; return 8 * (i >> 2) + 4 * n + (i & 3); }
struct Unit { int pm, pn; };
struct Gemm { const bf16* A; const bf16* Bt; int M, N, K, lda, ldb, acs; int ktA = 0; };
struct StaticOrder {
    int nM, nN, nwg, G, c, wgm, rev;
    __device__ void init(int M, int N, int G_, int c_, int rev_ = 0) { nM = M / BM; nN = N / BM; nwg = nM * nN; G = G_; c = c_; wgm = (nN == 8) ? 4 : WGM; rev = rev_; }
    __device__ bool next(int i, Unit& u) const {
        const long L = (long)i * G + c; if (L >= nwg) return false;
        int wgid = (int)L; { const int q = nwg / NXCD, r = nwg % NXCD, xcd = wgid % NXCD, off = wgid / NXCD; wgid = (xcd < r ? xcd * (q + 1) : r * (q + 1) + (xcd - r) * q) + off; }
        const int nig = wgm * nN, gid = wgid / nig, fm = gid * wgm, gsz = (nM - fm) < wgm ? (nM - fm) : wgm;
        u.pm = fm + ((wgid % nig) % gsz); u.pn = (wgid % nig) / gsz; if (rev) u.pm = nM - 1 - u.pm; return true;
    }
};
template <class Epi, bool ALIGN_EPI>
__device__ __forceinline__ void gemm_phase(LAS unsigned char* lds, const Gemm g, const StaticOrder& S, const Epi& E, const int tid) {
    const int wid = __builtin_amdgcn_readfirstlane(tid >> 6), lane = tid & 63, wr = wid >> 2, wc = wid & 3, fr = lane & 15, fq = lane >> 4;
    const int K = g.K, nt = K / BK;
    unsigned voffA[2], voffB[2];
#pragma unroll
    for (int i = 0; i < 2; ++i) { int R, C; stage_rc(tid * 16 + i * 8192, R, C); const int Rb = (R & ~31) + perm32(R & 31);
        voffA[i] = (unsigned)(R * g.lda + C) * 2u; voffB[i] = (unsigned)(Rb * g.ldb + C) * 2u; }
    const size_t kstep = (size_t)(BK * 2), kstepA = g.ktA ? (size_t)g.ktA : kstep;
    const size_t hstepA = (size_t)HALF * g.lda * 2, hstepB = (size_t)HALF * g.ldb * 2;
    const size_t tstepA = g.ktA ? (size_t)g.ktA * (size_t)nt : 2 * hstepA, tstepB = 2 * hstepB;
    const unsigned ldsw = (unsigned)wid * 1024u;
    const int aoff = lds_byte(wr * 64 + fr, fq * 8), boff = lds_byte(wc * 32 + fr, fq * 8);
#define PG8_SA(b, h) (((b) * 2 + (h)) * HTB)
#define PG8_SB(b, h) ((4 + (b) * 2 + (h)) * HTB)
#define PG8_STAGE(bufoff, gbase, voff) do { _Pragma("unroll") for (int _i = 0; _i < 2; ++_i) \
        __builtin_amdgcn_global_load_lds((const unsigned*)((const char*)(gbase) + (voff)[_i]), (LAS unsigned*)(lds + (bufoff) + ldsw + _i * 8192), 16, 0, 0); } while (0)
#define PG8_LDA(dst, b, h) do { _Pragma("unroll") for (int m = 0; m < 4; ++m) _Pragma("unroll") for (int k = 0; k < 2; ++k) dst[m][k] = *(const LAS bf16x8*)(lds + PG8_SA(b, h) + aoff + m * 2048 + k * 1024); } while (0)
#define PG8_LDB(dst, b, h) do { _Pragma("unroll") for (int n = 0; n < 2; ++n) _Pragma("unroll") for (int k = 0; k < 2; ++k) dst[n][k] = *(const LAS bf16x8*)(lds + PG8_SB(b, h) + boff + n * 2048 + k * 1024); } while (0)
#define PG8_MMA(ai, bj, At, Bt) do { __builtin_amdgcn_s_setprio(1); _Pragma("unroll") for (int m = 0; m < 4; ++m) _Pragma("unroll") for (int n = 0; n < 2; ++n) _Pragma("unroll") for (int k = 0; k < 2; ++k) \
        acc[ai][bj][m][n] = __builtin_amdgcn_mfma_f32_16x16x32_bf16(Bt[n][k], At[m][k], acc[ai][bj][m][n], 0, 0, 0); __builtin_amdgcn_s_setprio(0); } while (0)
#define PG8_WAIT_V(n) asm volatile("s_waitcnt vmcnt(" #n ")" ::: "memory")
#define PG8_WAIT_L(n) asm volatile("s_waitcnt lgkmcnt(" #n ")" ::: "memory")
#define PG8_BAR __builtin_amdgcn_s_barrier()
#define PG8_SCHED __builtin_amdgcn_sched_barrier(0)
    Unit cur, nxt; int ui = 0; int rs_pm = -1;
    if (!S.next(0, cur)) return;
    f32x4 acc[2][2][4][2];
#pragma unroll
    for (int a = 0; a < 2; ++a)
#pragma unroll
        for (int b = 0; b < 2; ++b)
#pragma unroll
            for (int m = 0; m < 4; ++m)
#pragma unroll
                for (int n = 0; n < 2; ++n) acc[a][b][m][n] = (f32x4){0.f, 0.f, 0.f, 0.f};
    bf16x8 At[4][2], B0[2][2], B1[2][2];
    const char* cA = (const char*)g.A + (size_t)cur.pm * tstepA + (size_t)cur.pn * g.acs; const char* cB = (const char*)g.Bt + (size_t)cur.pn * tstepB;
    PG8_STAGE(PG8_SB(0, 0), cB, voffB); PG8_STAGE(PG8_SB(0, 1), cB + hstepB, voffB); PG8_STAGE(PG8_SA(0, 0), cA, voffA); PG8_STAGE(PG8_SA(0, 1), cA + hstepA, voffA);
    if (wr == 1) PG8_BAR;
    PG8_WAIT_V(2); PG8_BAR;
    PG8_STAGE(PG8_SB(1, 0), cB + kstep, voffB); PG8_STAGE(PG8_SA(1, 0), cA + kstepA, voffA); PG8_STAGE(PG8_SB(1, 1), cB + hstepB + kstep, voffB);
    PG8_WAIT_V(6); PG8_BAR;
    for (;;) {
        const bool has_next = S.next(ui + 1, nxt);
        const char* nA = has_next ? (const char*)g.A + (size_t)nxt.pm * tstepA + (size_t)nxt.pn * g.acs : cA; const char* nB = has_next ? (const char*)g.Bt + (size_t)nxt.pn * tstepB : cB;
        for (int t = 0; t < nt; t += 2) {
            const bool last = (t == nt - 2);
            const char* a1 = cA + (size_t)(t + 1) * kstepA;
            const char* a2 = last ? nA : cA + (size_t)(t + 2) * kstepA; const char* b2 = last ? nB : cB + (size_t)(t + 2) * kstep;
            const char* a3 = a2 + kstepA; const char* b3 = b2 + kstep;
            PG8_LDB(B0, 0, 0); PG8_LDB(B1, 0, 1); PG8_SCHED; PG8_LDA(At, 0, 0); PG8_STAGE(PG8_SA(1, 1), a1 + hstepA, voffA);
            PG8_WAIT_V(8); PG8_WAIT_L(0); PG8_BAR; PG8_MMA(0, 0, At, B0); PG8_MMA(0, 1, At, B1); PG8_BAR; PG8_SCHED;
            PG8_LDA(At, 0, 1); PG8_STAGE(PG8_SB(0, 0), b2, voffB); PG8_STAGE(PG8_SB(0, 1), b2 + hstepB, voffB); PG8_STAGE(PG8_SA(0, 0), a2, voffA);
            PG8_WAIT_V(8); PG8_WAIT_L(0); PG8_BAR; PG8_MMA(1, 0, At, B0); PG8_MMA(1, 1, At, B1); PG8_BAR; PG8_SCHED;
            PG8_LDB(B0, 1, 0); PG8_LDB(B1, 1, 1); PG8_SCHED; PG8_LDA(At, 1, 0); PG8_STAGE(PG8_SA(0, 1), a2 + hstepA, voffA);
            PG8_WAIT_V(8); PG8_WAIT_L(0); PG8_BAR; PG8_MMA(0, 0, At, B0); PG8_MMA(0, 1, At, B1); PG8_BAR; PG8_SCHED;
            PG8_LDA(At, 1, 1); PG8_STAGE(PG8_SB(1, 0), b3, voffB); PG8_STAGE(PG8_SB(1, 1), b3 + hstepB, voffB); PG8_STAGE(PG8_SA(1, 0), a3, voffA);
            PG8_WAIT_V(8); PG8_WAIT_L(0); PG8_BAR; PG8_MMA(1, 0, At, B0); PG8_MMA(1, 1, At, B1); PG8_BAR; PG8_SCHED;
        }
        if constexpr (ALIGN_EPI) { if (wr == 0) PG8_BAR; }
        E(acc, cur, wr, wc, lds, rs_pm);
        if (!has_next) break;
        cur = nxt; cA = nA; cB = nB; ++ui;
        if constexpr (ALIGN_EPI) { if (wr == 1) PG8_BAR; }
    }
    PG8_WAIT_V(0);
    if constexpr (!ALIGN_EPI) { if (wr == 0) PG8_BAR; }
    PG8_BAR;
#undef PG8_SA
#undef PG8_SB
#undef PG8_STAGE
#undef PG8_LDA
#undef PG8_LDB
#undef PG8_MMA
#undef PG8_WAIT_V
#undef PG8_WAIT_L
#undef PG8_BAR
#undef PG8_SCHED
}

__device__ __forceinline__ u32x4 zero_frag() { unsigned z_ = 0u; asm volatile("" : "+v"(z_)); return (u32x4){z_, z_, z_, z_}; }
__device__ __forceinline__ void zero_acc(f32x4& a, u32x4& zb) { asm volatile("" : "+v"(zb));
    a = __builtin_amdgcn_mfma_f32_16x16x32_bf16(__builtin_bit_cast(bf16x8, zb), __builtin_bit_cast(bf16x8, zb), (f32x4){0.f, 0.f, 0.f, 0.f}, 0, 0, 0); }
__device__ __forceinline__ void epi_lane(int& fr, int& fq) { unsigned ones = ~0u; asm volatile("" : "+s"(ones)); const int ln = (int)__builtin_amdgcn_mbcnt_hi(ones, __builtin_amdgcn_mbcnt_lo(ones, 0u)); fr = ln & 15; fq = ln >> 4; }
__device__ __forceinline__ void load_rs(const float* part, int row0, int fq, float (&rs)[2][4]) {
#pragma unroll
    for (int ai = 0; ai < 2; ++ai)
#pragma unroll
        for (int m = 0; m < 4; ++m) {
            const f32x4* p = (const f32x4*)(part + (size_t)(row0 + ai * HALF + m * 16) * 32 + fq * 8);
            const f32x4 a = p[0], b = p[1];
            float s = ((a[0] + a[1]) + (a[2] + a[3])) + ((b[0] + b[1]) + (b[2] + b[3]));
            s += __shfl_xor(s, 16); s += __shfl_xor(s, 32);
            rs[ai][m] = __builtin_amdgcn_rsqf(s * (1.0f / D) + EPS);
        }
}
__device__ __forceinline__ void load_rs_cached(const float* part, int pm, int row0, int wid, int fr, int fq, LAS unsigned char* lds, int& rs_pm, float (&rs)[2][4]) {
    LAS float* rc = (LAS float*)(lds + RING_BYTES) + wid * 128 + fr;
    if (pm != rs_pm) {
        load_rs(part, row0, fq, rs); rs_pm = pm;
        if (fq == 0) {
#pragma unroll
            for (int q = 0; q < 8; ++q) rc[q * 16] = rs[q >> 2][q & 3]; }
    } else {
#pragma unroll
        for (int q = 0; q < 8; ++q) rs[q >> 2][q & 3] = rc[q * 16];
    }
}
struct EpiSwiGLU {
    bf16* H; const float* part;
    __device__ __forceinline__ void operator()(f32x4 (&acc)[2][2][4][2], const Unit& u, int wr, int wc, LAS unsigned char* lds, int& rs_pm) const {
        int fr, fq; epi_lane(fr, fq);
        const int row0 = u.pm * BM + wr * 64 + fr, col0 = u.pn * HALF + wc * 32 + 8 * fq;
        float rs[2][4]; load_rs_cached(part, u.pm, row0, wr * 4 + wc, fr, fq, lds, rs_pm, rs);
        u32x4 zb = zero_frag();
#pragma unroll
        for (int ai = 0; ai < 2; ++ai)
#pragma unroll
            for (int m = 0; m < 4; ++m) {
                const float r = rs[ai][m], rsn = r * -1.4426950408889634f, rs2 = r * r; float o[8];
                f32x4 av[2], gu[2];
#pragma unroll
                for (int n = 0; n < 2; ++n) { av[n] = acc[ai][0][m][n] * rsn; gu[n] = acc[ai][0][m][n] * acc[ai][1][m][n]; }
#pragma unroll
                for (int n = 0; n < 2; ++n) { zero_acc(acc[ai][0][m][n], zb); zero_acc(acc[ai][1][m][n], zb); }
#pragma unroll
                for (int n = 0; n < 2; ++n)
#pragma unroll
                    for (int j = 0; j < 4; ++j) av[n][j] = __builtin_amdgcn_exp2f(av[n][j]);
#pragma unroll
                for (int n = 0; n < 2; ++n) av[n] = av[n] + 1.0f;
#pragma unroll
                for (int n = 0; n < 2; ++n)
#pragma unroll
                    for (int j = 0; j < 4; ++j) av[n][j] = __builtin_amdgcn_rcpf(av[n][j]);
#pragma unroll
                for (int n = 0; n < 2; ++n) { const f32x4 q = gu[n] * (av[n] * rs2);
#pragma unroll
                    for (int j = 0; j < 4; ++j) o[n * 4 + j] = q[j]; }
                u32x4 w; w.x = cvt_pk_bf16(o[0], o[1]); w.y = cvt_pk_bf16(o[2], o[3]); w.z = cvt_pk_bf16(o[4], o[5]); w.w = cvt_pk_bf16(o[6], o[7]);
                *(u32x4*)(H + (((size_t)(u.pm * (DFF / 64) + u.pn * 2 + (wc >> 1)) * BM + (wr * 64 + fr + ai * HALF + m * 16)) * 64 + (wc & 1) * 32 + 8 * fq)) = w;
            }
    }
};
struct EpiScale {
    bf16* O; int ldc; const float* part;
    __device__ __forceinline__ void operator()(f32x4 (&acc)[2][2][4][2], const Unit& u, int wr, int wc, LAS unsigned char* lds, int& rs_pm) const {
        int fr, fq; epi_lane(fr, fq);
        const int row0 = u.pm * BM + wr * 64 + fr, col0 = u.pn * BM + wc * 32 + 8 * fq;
        float rs[2][4]; load_rs_cached(part, u.pm, row0, wr * 4 + wc, fr, fq, lds, rs_pm, rs);
        u32x4 zb = zero_frag();
#pragma unroll
        for (int ai = 0; ai < 2; ++ai)
#pragma unroll
            for (int m = 0; m < 4; ++m) { const float r = rs[ai][m]; bf16* rowp = O + (size_t)(row0 + ai * HALF + m * 16) * ldc + col0;
#pragma unroll
                for (int bj = 0; bj < 2; ++bj) { const f32x4 v0 = acc[ai][bj][m][0] * r, v1 = acc[ai][bj][m][1] * r; zero_acc(acc[ai][bj][m][0], zb); zero_acc(acc[ai][bj][m][1], zb);
                    u32x4 w; w.x = cvt_pk_bf16(v0[0], v0[1]); w.y = cvt_pk_bf16(v0[2], v0[3]); w.z = cvt_pk_bf16(v1[0], v1[1]); w.w = cvt_pk_bf16(v1[2], v1[3]);
                    *(u32x4*)(rowp + bj * HALF) = w; } }
    }
};
struct EpiColScale {
    bf16* O; int ldc; const float* cs;
    __device__ __forceinline__ void operator()(f32x4 (&acc)[2][2][4][2], const Unit& u, int wr, int wc, LAS unsigned char* lds, int& rs_pm) const {
        int fr, fq; epi_lane(fr, fq);
        const int row0 = u.pm * BM + wr * 64 + fr, col0 = u.pn * BM + wc * 32 + 8 * fq;
        f32x4 sv[2][2]; u32x4 zb = zero_frag();
#pragma unroll
        for (int bj = 0; bj < 2; ++bj)
#pragma unroll
            for (int n = 0; n < 2; ++n) sv[bj][n] = *(const f32x4*)(cs + col0 + bj * HALF + 4 * n);
#pragma unroll
        for (int ai = 0; ai < 2; ++ai)
#pragma unroll
            for (int m = 0; m < 4; ++m) { bf16* rowp = O + (size_t)(row0 + ai * HALF + m * 16) * ldc + col0;
#pragma unroll
                for (int bj = 0; bj < 2; ++bj) { const f32x4 v0 = acc[ai][bj][m][0] * sv[bj][0], v1 = acc[ai][bj][m][1] * sv[bj][1]; zero_acc(acc[ai][bj][m][0], zb); zero_acc(acc[ai][bj][m][1], zb);
                    u32x4 w; w.x = cvt_pk_bf16(v0[0], v0[1]); w.y = cvt_pk_bf16(v0[2], v0[3]); w.z = cvt_pk_bf16(v1[0], v1[1]); w.w = cvt_pk_bf16(v1[2], v1[3]);
                    *(u32x4*)(rowp + bj * HALF) = w; } }
    }
};
struct EpiResid {
    bf16* xb; float* part; float alpha;
    __device__ __forceinline__ void operator()(f32x4 (&acc)[2][2][4][2], const Unit& u, int wr, int wc, LAS unsigned char* lds, int& rs_pm) const {
        int fr, fq; epi_lane(fr, fq);
        const int row0 = u.pm * BM + wr * 64 + fr, col0 = u.pn * BM + wc * 32 + 8 * fq; u32x4 zb = zero_frag();
#pragma unroll
        for (int ai = 0; ai < 2; ++ai)
#pragma unroll
            for (int m = 0; m < 4; ++m) { const size_t oo = (size_t)(row0 + ai * HALF + m * 16) * D + col0; float ss = 0.f;
#pragma unroll
                for (int bj = 0; bj < 2; ++bj) {
                    const u32x4 xw = *(const u32x4*)(xb + oo + bj * HALF);
                    const f32x4 x0 = (f32x4){bflo(xw.x), bfhi(xw.x), bflo(xw.y), bfhi(xw.y)}, x1 = (f32x4){bflo(xw.z), bfhi(xw.z), bflo(xw.w), bfhi(xw.w)};
                    const f32x4 v0 = x0 + acc[ai][bj][m][0] * alpha, v1 = x1 + acc[ai][bj][m][1] * alpha; zero_acc(acc[ai][bj][m][0], zb); zero_acc(acc[ai][bj][m][1], zb);
                    ss += (v0[0] * v0[0] + v0[1] * v0[1]) + (v0[2] * v0[2] + v0[3] * v0[3]) + (v1[0] * v1[0] + v1[1] * v1[1]) + (v1[2] * v1[2] + v1[3] * v1[3]);
                    u32x4 w; w.x = cvt_pk_bf16(v0[0], v0[1]); w.y = cvt_pk_bf16(v0[2], v0[3]); w.z = cvt_pk_bf16(v1[0], v1[1]); w.w = cvt_pk_bf16(v1[2], v1[3]);
                    *(u32x4*)(xb + oo + bj * HALF) = w; }
                ss += __shfl_xor(ss, 16); ss += __shfl_xor(ss, 32);
                if (fq == 0) part[(size_t)(row0 + ai * HALF + m * 16) * 32 + u.pn * 4 + wc] = ss;
                asm volatile("" ::: "memory"); }
    }
};
}


namespace att {
typedef short s16x4 __attribute__((ext_vector_type(4)));
constexpr int SHM_V = 64 * 128 * 2, SHM_K = 64 * 128 * 2;
#define ATT_KSWZ(row, colB) ((row) * 256 + ((colB) ^ (((row) & 7) << 4)))
__device__ __forceinline__ int crow(int r, int hi) { return (r & 3) + 8 * (r >> 2) + 4 * hi; }
__device__ __forceinline__ int v_st(int k, int c) { const int kk = (k & ~0xC) | ((k & 4) << 1) | ((k & 8) >> 1); return ((kk >> 3) * 4 + (c >> 5)) * 512 + ((kk & 7) * 32 + (c & 31)) * 2; }
__device__ __forceinline__ int v_rd_base(int lane) { return ((lane & 3) << 3) | (((lane >> 2) & 3) << 6) | (((lane >> 4) & 1) << 5) | (((lane >> 5) & 1) << 8); }
constexpr int v_rd_off(int d0, int ks, int half) { return d0 * 512 + ks * 4096 + half * 2048; }
template <int OFF> __device__ __forceinline__ s16x4 tr_read(int vb) {
    s16x4 r; asm volatile("ds_read_b64_tr_b16 %0, %1 offset:%2" : "=&v"(r) : "v"(vb), "i"(OFF) : "memory"); return r;
}
template <int D0> __device__ __forceinline__ void pv_one(f32x16& od, int vb, bf16x8 pa0, bf16x8 pa1, bf16x8 pa2, bf16x8 pa3) {
    const s16x4 l0 = tr_read<v_rd_off(D0, 0, 0)>(vb), h0 = tr_read<v_rd_off(D0, 0, 1)>(vb), l1 = tr_read<v_rd_off(D0, 1, 0)>(vb), h1 = tr_read<v_rd_off(D0, 1, 1)>(vb);
    const s16x4 l2 = tr_read<v_rd_off(D0, 2, 0)>(vb), h2 = tr_read<v_rd_off(D0, 2, 1)>(vb), l3 = tr_read<v_rd_off(D0, 3, 0)>(vb), h3 = tr_read<v_rd_off(D0, 3, 1)>(vb);
    asm volatile("s_waitcnt lgkmcnt(0)" ::: "memory"); __builtin_amdgcn_sched_barrier(0);
#define ATT_PK(L, H) (bf16x8){L[0], L[1], L[2], L[3], H[0], H[1], H[2], H[3]}
    od = __builtin_amdgcn_mfma_f32_32x32x16_bf16(pa0, ATT_PK(l0, h0), od, 0, 0, 0);
    od = __builtin_amdgcn_mfma_f32_32x32x16_bf16(pa1, ATT_PK(l1, h1), od, 0, 0, 0);
    od = __builtin_amdgcn_mfma_f32_32x32x16_bf16(pa2, ATT_PK(l2, h2), od, 0, 0, 0);
    od = __builtin_amdgcn_mfma_f32_32x32x16_bf16(pa3, ATT_PK(l3, h3), od, 0, 0, 0);
#undef ATT_PK
}
__device__ __forceinline__ int t5_bucket(int rel) { const int n = rel < 0 ? -rel : rel; int bk = rel > 0 ? 16 : 0;
    if (n < 8) bk += n; else { const int lg = (31 - __builtin_clz((unsigned)(n * n))) - 6; bk += min(8 + lg, 15); } return bk; }

__device__ __forceinline__ void attn_unit(const bf16* QKVb, bf16* AMIXb, const float* sinkp, const float* relb, int u, LAS unsigned char* lds, int tid, int lane, int wave, int& tab_key) {
    asm volatile("" : "+v"(lane));
    const int gb = u >> 3, kv = (u >> 1) & 3, hp = u & 1;
    int s0, nblk, nb; if (gb < 64) { s0 = 0; nblk = 64; nb = gb; } else { const int r = gb - 64; s0 = TP + (r >> 4) * LS; nblk = 16; nb = r & 15; }
    const int r32 = lane & 31, hi = lane >> 5, hsel = wave >> 2, qa = wave & 3, head = kv * 4 + hp * 2 + hsel;
    const int q0 = s0 + nb * 128;
    LAS unsigned char* V_lds = lds; LAS unsigned char* K_lds = lds + 2 * SHM_V;
    LAS float* wsc = (LAS float*)(lds + 2 * SHM_V + 2 * SHM_K) + wave * 64; LAS float* tab = (LAS float*)(lds + 2 * SHM_V + 2 * SHM_K + 2048);
    constexpr float LOG2E = 1.4426950408889634f, C = 0.08838834764831845f * LOG2E;
    __syncthreads();
    if ((u & 7) != tab_key) { tab_key = u & 7;
    for (int e = tid; e < 1024; e += 512) { const int hs = e >> 9, idx = e & 511, rel = idx - 255; float v = -1e30f;
        if (rel >= -128 && rel <= 128) v = relb[t5_bucket(rel) * 16 + kv * 4 + hp * 2 + hs] * LOG2E;
        tab[e] = v; } }
    const bf16* Qw = QKVb + (size_t)(q0 + qa * 32 + r32) * QKV + head * 128 + hi * 8;
    bf16x8 qr[8];
#pragma unroll
    for (int d0 = 0; d0 < 8; ++d0) qr[d0] = *(const bf16x8*)(Qw + d0 * 16);
    const int jfirst = nb > 0 ? 0 : 2, jlast = nb < nblk - 1 ? 5 : 3;
    const bf16* Kg = QKVb + 2048 + kv * 128; const bf16* Vg = QKVb + 2560 + kv * 128;
    const int sr = tid >> 4, sc = (tid & 15) * 8, vst0 = v_st(sr, sc), vst1 = v_st(32 + sr, sc);
    const int vb0 = (int)(unsigned)(uintptr_t)V_lds + v_rd_base(lane);
    bf16x8 ks0, ks1, vs0, vs1;
#define ATT_TKEY(j) (q0 + ((j) >> 1) * 128 - 128 + ((j) & 1) * 64)
#define ATT_SLOAD(j) do { const size_t k0_ = (size_t)ATT_TKEY(j); ks0 = *(const bf16x8*)(Kg + (k0_ + sr) * QKV + sc); ks1 = *(const bf16x8*)(Kg + (k0_ + 32 + sr) * QKV + sc); \
        vs0 = *(const bf16x8*)(Vg + (k0_ + sr) * QKV + sc); vs1 = *(const bf16x8*)(Vg + (k0_ + 32 + sr) * QKV + sc); } while (0)
#define ATT_SWRITE(b) do { *(LAS bf16x8*)(V_lds + (b) * SHM_V + vst0) = vs0; *(LAS bf16x8*)(V_lds + (b) * SHM_V + vst1) = vs1; \
        *(LAS bf16x8*)(K_lds + (b) * SHM_K + ATT_KSWZ(sr, sc * 2)) = ks0; *(LAS bf16x8*)(K_lds + (b) * SHM_K + ATT_KSWZ(32 + sr, sc * 2)) = ks1; } while (0)
    const float sink2 = sinkp[head] * LOG2E;
    float m_reg = sink2, l_reg = 0.f;
    f32x16 o[4];
#pragma unroll
    for (int d = 0; d < 4; ++d)
#pragma unroll
        for (int r = 0; r < 16; ++r) o[d][r] = 0.f;
    ATT_SLOAD(jfirst); asm volatile("s_waitcnt vmcnt(0)" ::: "memory"); ATT_SWRITE(0); __syncthreads();
    for (int j = jfirst; j <= jlast; ++j) {
        const int b = (j - jfirst) & 1;
        if (j < jlast) ATT_SLOAD(j + 1);
        if (!((j == 0 && qa >= 2) || (j == 5 && qa < 2))) {
        f32x16 p0, p1;
#pragma unroll
        for (int r = 0; r < 16; ++r) { p0[r] = 0.f; p1[r] = 0.f; }
        { const LAS unsigned char* Ks = K_lds + b * SHM_K;
#pragma unroll
          for (int d0 = 0; d0 < 8; ++d0) { const int cb = (d0 * 16 + hi * 8) * 2;
              const bf16x8 b0 = *(const LAS bf16x8*)(Ks + ATT_KSWZ(r32, cb)), b1 = *(const LAS bf16x8*)(Ks + ATT_KSWZ(32 + r32, cb));
              p0 = __builtin_amdgcn_mfma_f32_32x32x16_bf16(b0, qr[d0], p0, 0, 0, 0);
              p1 = __builtin_amdgcn_mfma_f32_32x32x16_bf16(b1, qr[d0], p1, 0, 0, 0); } }
        { const int koff = ((j >> 1) - 1) * 128 + (j & 1) * 64;
          const LAS float* tb = tab + hsel * 512 + (koff - (qa * 32 + r32) + 255 + 4 * hi);
#pragma unroll
          for (int r = 0; r < 16; ++r) { p0[r] = fmaf(p0[r], C, tb[(r & 3) + 8 * (r >> 2)]); p1[r] = fmaf(p1[r], C, tb[32 + (r & 3) + 8 * (r >> 2)]); } }
        float pmax = p0[0];
#pragma unroll
        for (int r = 1; r < 16; ++r) pmax = fmaxf(pmax, p0[r]);
#pragma unroll
        for (int r = 0; r < 16; ++r) pmax = fmaxf(pmax, p1[r]);
        { auto rr = __builtin_amdgcn_permlane32_swap(__float_as_uint(pmax), __float_as_uint(pmax), false, false); pmax = fmaxf(__uint_as_float(rr[0]), __uint_as_float(rr[1])); }
        const float mn = fmaxf(m_reg, pmax), alpha = __builtin_amdgcn_exp2f(m_reg - mn); m_reg = mn;
        float ps = 0.f;
#pragma unroll
        for (int r = 0; r < 16; ++r) { p0[r] = __builtin_amdgcn_exp2f(p0[r] - mn); p1[r] = __builtin_amdgcn_exp2f(p1[r] - mn); ps += p0[r] + p1[r]; }
        { auto rr = __builtin_amdgcn_permlane32_swap(__float_as_uint(ps), __float_as_uint(ps), false, false); ps = __uint_as_float(rr[0]) + __uint_as_float(rr[1]); }
        l_reg = l_reg * alpha + ps;
        if (__any(alpha < 1.f)) { if (hi == 0) wsc[r32] = alpha; asm volatile("s_waitcnt lgkmcnt(0)" ::: "memory");
#pragma unroll
            for (int r = 0; r < 16; ++r) { const float al = wsc[crow(r, hi)];
#pragma unroll
                for (int d = 0; d < 4; ++d) o[d][r] *= al; }
            asm volatile("s_waitcnt lgkmcnt(0)" ::: "memory"); }
        bf16x8 pa0, pa1, pa2, pa3;
#define ATT_PK4(P, BASE, OUT) do { unsigned a0 = cvt_pk_bf16(P[BASE + 0], P[BASE + 1]), a1 = cvt_pk_bf16(P[BASE + 2], P[BASE + 3]);   \
        unsigned b0 = cvt_pk_bf16(P[BASE + 4], P[BASE + 5]), b1 = cvt_pk_bf16(P[BASE + 6], P[BASE + 7]);                              \
        auto r0 = __builtin_amdgcn_permlane32_swap(a0, b0, false, false); auto r1 = __builtin_amdgcn_permlane32_swap(a1, b1, false, false); \
        u32x4 w = {r0[0], r1[0], r0[1], r1[1]}; OUT = __builtin_bit_cast(bf16x8, w); } while (0)
        ATT_PK4(p0, 0, pa0); ATT_PK4(p0, 8, pa1); ATT_PK4(p1, 0, pa2); ATT_PK4(p1, 8, pa3);
#undef ATT_PK4
        { const int vb = vb0 + b * SHM_V;
          pv_one<0>(o[0], vb, pa0, pa1, pa2, pa3); pv_one<1>(o[1], vb, pa0, pa1, pa2, pa3); pv_one<2>(o[2], vb, pa0, pa1, pa2, pa3); pv_one<3>(o[3], vb, pa0, pa1, pa2, pa3); }
        }
        if (j < jlast) { asm volatile("s_waitcnt vmcnt(0)" ::: "memory"); ATT_SWRITE(b ^ 1); }
        __syncthreads();
    }
    l_reg += __builtin_amdgcn_exp2f(sink2 - m_reg);
    if (hi == 0) wsc[r32] = l_reg; asm volatile("s_waitcnt lgkmcnt(0)" ::: "memory");
    bf16* Ow = AMIXb + (size_t)(q0 + qa * 32) * D + head * 128 + r32;
#pragma unroll
    for (int r = 0; r < 16; ++r) { const int orow = crow(r, hi); const float rl = __builtin_amdgcn_rcpf(wsc[orow]);
#pragma unroll
        for (int d0 = 0; d0 < 4; ++d0) Ow[(size_t)orow * D + d0 * 32] = (bf16)f2bf(o[d0][r] * rl); }
    asm volatile("s_waitcnt lgkmcnt(0)" ::: "memory");
#undef ATT_TKEY
#undef ATT_SLOAD
#undef ATT_SWRITE
}
}

struct Args { const float* in[30]; float* out; unsigned char* ws; int ph_lo, ph_hi; };
typedef const Args __attribute__((address_space(4)))* KArgs;
enum { I_XP = 0, I_XS, I_NF1, I_F1WI, I_F1WO, I_NMIX, I_ABIN, I_POOLW, I_POOLS, I_HCW, I_HCB, I_HW1, I_HB1, I_HW2, I_HB2, I_HW3, I_HB3, I_HW4, I_HB4, I_HFREQ, I_HD,
       I_ABOUT, I_WQKV, I_WO, I_SINK, I_RELB, I_NF2, I_F2WI, I_F2WO, I_NFIN };

struct Mat { const float* src; const float* gain; bf16* dst; int K, N, srcN, swi; };
constexpr int NMAT = 34;
__device__ __forceinline__ Mat get_mat(KArgs a, int mi) {
    Mat m; m.gain = nullptr; m.swi = 0;
    unsigned char* ws = a->ws;
    if (mi < 16) { const int l = mi >> 2, w = mi & 3; unsigned char* fb = ws + WS_W + (size_t)(l * 2 + (w >> 1)) * SZ_FFN;
        if ((w & 1) == 0) { m.src = a->in[(w >> 1) ? I_F2WI : I_F1WI] + (size_t)l * D * 2 * DFF; m.gain = a->in[(w >> 1) ? I_NF2 : I_NF1] + l * D; m.dst = (bf16*)fb; m.K = D; m.N = 2 * DFF; m.srcN = 2 * DFF; m.swi = 1; }
        else { m.src = a->in[(w >> 1) ? I_F2WO : I_F1WO] + (size_t)l * DFF * D; m.dst = (bf16*)(fb + SZ_WI); m.K = DFF; m.N = D; m.srcN = D; }
        return m; }
    mi -= 16;
    if (mi < 10) { const int i = mi / 5, w = mi % 5; unsigned char* mb = ws + WS_WMIX + (size_t)i * SZ_MIX;
        if (w == 0) { m.src = a->in[I_ABIN] + (size_t)i * D * ABIN; m.gain = a->in[I_NMIX] + (2 * i) * D; m.dst = (bf16*)mb; m.K = D; m.N = ABIN; m.srcN = ABIN; }
        else if (w == 1) { m.src = a->in[I_ABOUT] + (size_t)i * D * D; m.dst = (bf16*)(mb + SZ_ABIN); m.K = D; m.N = D; m.srcN = D; }
        else if (w == 2) { m.src = a->in[I_WQKV] + (size_t)i * D * QKV; m.gain = a->in[I_NMIX] + (2 * i + 1) * D; m.dst = (bf16*)(mb + SZ_ABIN + SZ_DD + SZ_POOL); m.K = D; m.N = QKV; m.srcN = QKV; }
        else if (w == 3) { m.src = a->in[I_WO] + (size_t)i * D * D; m.dst = (bf16*)(mb + SZ_ABIN + SZ_DD + SZ_POOL + SZ_QKV); m.K = D; m.N = D; m.srcN = D; }
        else { m.src = a->in[I_POOLW] + (size_t)i * 4 * 65536; m.dst = (bf16*)(mb + SZ_ABIN + SZ_DD); m.K = 256; m.N = 256; m.srcN = 256; }
        return m; }
    mi -= 10;
    { const int i = mi / 3, gq = 1 + mi % 3; unsigned char* mb = ws + WS_WMIX + (size_t)i * SZ_MIX;
      m.src = a->in[I_POOLW] + (size_t)(i * 4 + gq) * 65536; m.dst = (bf16*)(mb + SZ_ABIN + SZ_DD) + (size_t)gq * 65536; m.K = 256; m.N = 256; m.srcN = 256; }
    return m;
}
constexpr int NMAT_USED = 32;

__device__ __forceinline__ void cvt_item(const Mat& mt, int item, int lane) {
    const int nblk = mt.N / 64, kb = item / nblk, nb = item % nblk, k0 = 64 * kb, n0 = 64 * nb;
    int s0 = n0;
    if (mt.swi) { const int pn = n0 >> 8, half = (n0 >> 7) & 1, jj = n0 & 127; s0 = half * DFF + 128 * pn + jj; }
    const int kg = lane >> 4, nq = lane & 15;
    const float* src = mt.src + (size_t)(k0 + 16 * kg) * mt.srcN + s0 + 4 * nq;
    f32x4 v[16];
#pragma unroll
    for (int i = 0; i < 16; ++i) v[i] = *(const f32x4*)(src + (size_t)i * mt.srcN);
    if (mt.gain) { const f32x4* g4 = (const f32x4*)(mt.gain + k0 + 16 * kg);
#pragma unroll
        for (int q = 0; q < 4; ++q) { const f32x4 g = g4[q];
#pragma unroll
            for (int x = 0; x < 4; ++x) v[4 * q + x] = v[4 * q + x] * g[x]; } }
    bf16* dst = mt.dst + (size_t)(n0 + 4 * nq) * mt.K + k0 + 16 * kg;
#pragma unroll
    for (int e = 0; e < 4; ++e)
#pragma unroll
        for (int h = 0; h < 2; ++h) { u32x4 o;
            o.x = cvt_pk_bf16(v[8 * h + 0][e], v[8 * h + 1][e]); o.y = cvt_pk_bf16(v[8 * h + 2][e], v[8 * h + 3][e]);
            o.z = cvt_pk_bf16(v[8 * h + 4][e], v[8 * h + 5][e]); o.w = cvt_pk_bf16(v[8 * h + 6][e], v[8 * h + 7][e]);
            *(u32x4*)(dst + (size_t)e * mt.K + 8 * h) = o; }
}


__device__ __forceinline__ int mat_slot(int mi) {
    return 0;
    if (mi < 16) { const int l = mi >> 2, w = mi & 3; return l == 0 ? 0 : (l == 1 ? 1 : (l == 2 ? (w < 2 ? 0 : 2) : 2)); }
    if (mi < 26) { const int i = (mi - 16) / 5, w = (mi - 16) % 5; if (i == 0) return (w == 2 || w == 3) ? 1 : 0; return w == 0 ? 0 : ((w == 1 || w == 4) ? 1 : 2); }
    return mi < 29 ? 0 : 1;
}
__device__ __forceinline__ void cvt_slot(KArgs ka, int slot, int wv, int nw, int lane) {
    int mi = -1; Mat mt; long base = 0; int cnt = 0;
    for (long it = wv; ; it += nw) {
        while (it >= base + cnt) { base += cnt; cnt = 0; do { ++mi; } while (mi < NMAT_USED && mat_slot(mi) != slot); if (mi >= NMAT_USED) break; mt = get_mat(ka, mi); cnt = (mt.K / 64) * (mt.N / 64); }
        if (mi >= NMAT_USED) break;
        cvt_item(mt, (int)(it - base), lane);
    }
}

__device__ __forceinline__ void filter_job(KArgs a, int jb, LAS float* sm, int tid) {
    const int i = jb / 320, r = jb % 320, lsel = r < 256 ? 0 : 1, tile = lsel ? r - 256 : r, L = lsel ? LS : TP, j0 = tile * 32;
    LAS float* zb = sm; LAS float* ha = sm + 32 * 36; LAS float* hb = ha + 32 * 64;
    const float* w1 = a->in[I_HW1] + i * 33 * 64; const float* b1 = a->in[I_HB1] + i * 64; const float* w2 = a->in[I_HW2] + i * 4096; const float* b2 = a->in[I_HB2] + i * 64;
    const float* w3 = a->in[I_HW3] + i * 4096; const float* b3 = a->in[I_HB3] + i * 64; const float* w4 = a->in[I_HW4] + (size_t)i * 64 * 2048; const float* b4 = a->in[I_HB4] + i * 2048;
    const float* fq = a->in[I_HFREQ] + i * 64;
    const int jj = tid >> 4, og = tid & 15;
    { const int j = j0 + jj; const float wj = 6.283185307179586f * (float)j / (float)L; const float fb = 1e-4f + (float)og * ((15.0f - 1e-4f) / 15.0f); const float ang = fb * wj;
      zb[jj * 36 + 1 + og] = cosf(ang); zb[jj * 36 + 17 + og] = -sinf(ang); if (og == 0) zb[jj * 36] = (float)j / (float)(L - 1); }
    __syncthreads();
    { float acc[4];
#pragma unroll
      for (int q = 0; q < 4; ++q) acc[q] = b1[og * 4 + q];
#pragma unroll 3
      for (int e = 0; e < 33; ++e) { const float z = zb[jj * 36 + e]; const f32x4 w = *(const f32x4*)(w1 + e * 64 + og * 4);
#pragma unroll
          for (int q = 0; q < 4; ++q) acc[q] += z * w[q]; }
#pragma unroll
      for (int q = 0; q < 4; ++q) ha[jj * 64 + og * 4 + q] = sinf(fq[og * 4 + q] * acc[q]); }
    __syncthreads();
    { float acc[4];
#pragma unroll
      for (int q = 0; q < 4; ++q) acc[q] = b2[og * 4 + q];
#pragma unroll 4
      for (int e = 0; e < 64; ++e) { const float z = ha[jj * 64 + e]; const f32x4 w = *(const f32x4*)(w2 + e * 64 + og * 4);
#pragma unroll
          for (int q = 0; q < 4; ++q) acc[q] += z * w[q]; }
#pragma unroll
      for (int q = 0; q < 4; ++q) hb[jj * 64 + og * 4 + q] = sinf(fq[og * 4 + q] * acc[q]); }
    __syncthreads();
    { float acc[4];
#pragma unroll
      for (int q = 0; q < 4; ++q) acc[q] = b3[og * 4 + q];
#pragma unroll 4
      for (int e = 0; e < 64; ++e) { const float z = hb[jj * 64 + e]; const f32x4 w = *(const f32x4*)(w3 + e * 64 + og * 4);
#pragma unroll
          for (int q = 0; q < 4; ++q) acc[q] += z * w[q]; }
#pragma unroll
      for (int q = 0; q < 4; ++q) ha[jj * 64 + og * 4 + q] = sinf(fq[og * 4 + q] * acc[q]); }
    __syncthreads();
    const int c4 = tid * 4, ch = c4 & 1023; const bool isb = c4 >= 1024;
    bf16* KT = (bf16*)(a->ws + WS_KT + (size_t)i * SZ_KT1 + (lsel ? (size_t)2 * TP * 1024 * 2 : 0));
    float* kp = (float*)(a->ws + WS_KPART) + ((size_t)i * 320 + r) * 2048;
    const float dmin = -3.0701134573253945f, dmax = -15.350567286626973f;
    float ad[4];
#pragma unroll
    for (int q = 0; q < 4; ++q) ad[q] = fabsf(dmin + (float)(ch + q) * ((dmax - dmin) / 1023.0f));
    const f32x4 bias = *(const f32x4*)(b4 + c4);
    float asum[4] = {0.f, 0.f, 0.f, 0.f};
    for (int grp = 0; grp < 4; ++grp) {
        float acc[8][4];
#pragma unroll
        for (int q = 0; q < 8; ++q)
#pragma unroll
            for (int x = 0; x < 4; ++x) acc[q][x] = bias[x];
#pragma unroll 8
        for (int k = 0; k < 64; ++k) { const f32x4 w = *(const f32x4*)(w4 + (size_t)k * 2048 + c4);
#pragma unroll
            for (int q = 0; q < 8; ++q) { const float hv = ha[(grp * 8 + q) * 64 + k];
#pragma unroll
                for (int x = 0; x < 4; ++x) acc[q][x] += hv * w[x]; } }
#pragma unroll
        for (int q = 0; q < 8; ++q) { const int j = j0 + grp * 8 + q; const float tj = (float)j / (float)(L - 1); float v[4];
#pragma unroll
            for (int x = 0; x < 4; ++x) v[x] = acc[q][x] * expf(-tj * ad[x]);
            if (!(isb && j == 0)) {
#pragma unroll
                for (int x = 0; x < 4; ++x) asum[x] += fabsf(v[x]);
                const int m = isb ? L - j : L + j;
                u32x2 w; w.x = pk2(v[0], v[1]); w.y = pk2(v[2], v[3]);
                *(u32x2*)(KT + (size_t)m * 1024 + ch) = w; } }
    }
    *(f32x4*)(kp + c4) = (f32x4){asum[0], asum[1], asum[2], asum[3]};
    if (tile == 0 && tid < 256) *(u32x2*)(KT + tid * 4) = (u32x2){0u, 0u};
    __syncthreads();
}


__device__ __forceinline__ void r_transpose_tile(const bf16* KTb, bf16* Rb, int L, int tile, LAS unsigned short* sm, int tid) {
    const int mb = tile >> 4, cb = tile & 15, m0 = mb * 64, c0 = cb * 64;
    { const int mr = tid >> 3, cq = tid & 7; const u32x4 v = *(const u32x4*)(KTb + (size_t)(m0 + mr) * 1024 + c0 + 8 * cq);
      LAS unsigned* d = (LAS unsigned*)(sm + mr * 66 + 8 * cq); d[0] = v.x; d[1] = v.y; d[2] = v.z; d[3] = v.w; }
    __syncthreads();
    { const int cc = tid >> 3, mq = tid & 7; bf16* rrow = Rb + (size_t)(c0 + cc) * 2 * L;
#pragma unroll
      for (int k = 0; k < 8; ++k) { const int mm = mq + 8 * k, m = m0 + mm; const unsigned short val = sm[mm * 66 + cc];
          if (m == 0) rrow[0] = 0; else rrow[2 * L - m] = val; } }
    __syncthreads();
}

template <int RHO> __device__ __forceinline__ bf16x8 shift_frag(const u32x4& c0, const u32x4& c1) {
    const unsigned w[8] = {c0.x, c0.y, c0.z, c0.w, c1.x, c1.y, c1.z, c1.w}; u32x4 o;
    if constexpr ((RHO & 1) == 0) { o.x = w[RHO / 2]; o.y = w[RHO / 2 + 1]; o.z = w[RHO / 2 + 2]; o.w = w[RHO / 2 + 3]; }
    else { constexpr int b = RHO / 2; o.x = __builtin_amdgcn_alignbit(w[b + 1], w[b], 16); o.y = __builtin_amdgcn_alignbit(w[b + 2], w[b + 1], 16);
           o.z = __builtin_amdgcn_alignbit(w[b + 3], w[b + 2], 16); o.w = __builtin_amdgcn_alignbit(w[b + 4], w[b + 3], 16); }
    return __builtin_bit_cast(bf16x8, o);
}

typedef unsigned u32x4a4 __attribute__((ext_vector_type(4), aligned(4)));
template <bool PROMPT, int HALF>
__device__ __forceinline__ void conv_item(unsigned char* ws, KArgs ka, int ib, int oct, int g, LAS unsigned char* lds, int tid, int lane, int wave) {
    constexpr int L = PROMPT ? TP : LS;
    { unsigned ones_ = ~0u; asm volatile("" : "+s"(ones_)); lane = (int)__builtin_amdgcn_mbcnt_hi(ones_, __builtin_amdgcn_mbcnt_lo(ones_, 0u)); }
    const int c = oct * 8 + wave, c0 = oct * 8;
    const bf16* Rc = (const bf16*)(ws + WS_R) + (PROMPT ? (size_t)0 : (size_t)2 * TP * 1024) + (size_t)c * 2 * L + L;
    const int nn = lane & 15, kq = lane >> 4;
    const int xa = 8 * kq - 2 * nn;
    LAS unsigned char* vl = lds + wave * (33 * 528);
    { const bf16* Vg = (const bf16*)(ws + WS_VVT) + (size_t)c * T + (PROMPT ? 0 : TP + 4 * g * LS);
      __syncthreads();
#pragma unroll 4
      for (int it = 0; it < 16; ++it) { const int s_ = (it * 64 + lane) * 8; *(LAS u32x4*)(vl + (s_ >> 8) * 528 + (s_ & 255) * 2) = *(const u32x4*)(Vg + s_); }
      unsigned zz_ = 0u; asm volatile("" : "+v"(zz_));
      if (lane < 33) *(LAS u32x4*)(vl + 32 * 528 + lane * 16) = (u32x4){zz_, zz_, zz_, zz_}; }
    constexpr int NB = PROMPT ? 32 : 8, GS = PROMPT ? 16 : 4;
    const int nbv = PROMPT ? nn : (nn >> 2);
    LAS unsigned char* vcol = vl + 16 * kq + (PROMPT ? 0 : 8 * (nn & 3)) * 528;
    const int zrow = PROMPT ? 32 : 32 - 8 * (nn & 3);
    constexpr int W = (HALF == 2) ? 8 : 4, MO = (HALF == 1) ? 4 : 0;
    f32x4 acc[2][W][2];
#pragma unroll
    for (int r = 0; r < 2; ++r)
#pragma unroll
        for (int q = 0; q < W; ++q)
#pragma unroll
            for (int gg = 0; gg < 2; ++gg) acc[r][q][gg] = (f32x4){0.f, 0.f, 0.f, 0.f};
    constexpr int E0 = PROMPT ? -255 : -63, E1 = PROMPT ? -135 : -39, E2 = PROMPT ? 129 : 33, E3 = PROMPT ? 257 : 65;
    static_assert((E1 - E0) % 8 == 0 && (E2 - E1) % 8 == 0 && (E3 - E2) % 8 == 0, "segments are whole 8-step blocks");
    constexpr int DA = (HALF == 2) ? 2 : 4;
    u32x4 rh[DA]; unsigned rl[DA];
    u32x4 F0[W], F1[W];
#define CONV_LOADA(e_, k_) do { const int xh_ = min(32 * (e_) + xa, L - 8); rh[k_] = *(const u32x4a4*)(Rc + xh_); asm volatile("" ::: "memory"); rl[k_] = *(const unsigned*)(Rc + xh_ - 2); } while (0)
#define CONV_LDF(m_, gsel_, dst_) do { const int rr_ = nbv + (gsel_) * GS + ((m_) >> 3); const int row_ = ((unsigned)rr_ < (unsigned)NB) ? rr_ : zrow; \
        dst_ = *(const LAS u32x4*)(vcol + row_ * 528 + 64 * ((m_) & 7)); } while (0)
#define CONV_MM(r0_, q_, gg_, a_, f_) acc[r0_][q_][gg_] = __builtin_amdgcn_mfma_f32_16x16x32_bf16(a_, __builtin_bit_cast(bf16x8, f_), acc[r0_][q_][gg_], 0, 0, 0)
#define CONV_STEP(j, DO0, DO1) do { const int ee_ = e + (j); \
        const u32x4 ah_ = rh[(j) % DA]; const unsigned al_ = rl[(j) % DA]; \
        CONV_LOADA(ee_ + DA, (j) % DA); \
        asm volatile("" ::: "memory"); \
        u32x4 as_; as_.x = __builtin_amdgcn_alignbit(ah_.x, al_, 16); as_.y = __builtin_amdgcn_alignbit(ah_.y, ah_.x, 16); as_.z = __builtin_amdgcn_alignbit(ah_.z, ah_.y, 16); as_.w = __builtin_amdgcn_alignbit(ah_.w, ah_.z, 16); \
        const bf16x8 a0_ = __builtin_bit_cast(bf16x8, ah_), a1_ = __builtin_bit_cast(bf16x8, as_); \
        __builtin_amdgcn_s_setprio(1); \
        if (DO0) { CONV_MM(0, 0, 0, a0_, F0[(j) % W]); CONV_MM(1, 0, 0, a1_, F0[(j) % W]); } \
        if (DO1) { CONV_MM(0, 0, 1, a0_, F1[(j) % W]); CONV_MM(1, 0, 1, a1_, F1[(j) % W]); } \
        if (DO0) CONV_LDF(ee_ + MO + W, 0, F0[(j) % W]); \
        if (DO1) CONV_LDF(ee_ + MO + W, 1, F1[(j) % W]); \
        _Pragma("unroll") for (int q_ = 1; q_ < W; ++q_) { \
            if (DO0) { CONV_MM(0, q_, 0, a0_, F0[((j) + q_) % W]); CONV_MM(1, q_, 0, a1_, F0[((j) + q_) % W]); } \
            if (DO1) { CONV_MM(0, q_, 1, a0_, F1[((j) + q_) % W]); CONV_MM(1, q_, 1, a1_, F1[((j) + q_) % W]); } } \
        __builtin_amdgcn_s_setprio(0); \
        __builtin_amdgcn_sched_barrier(0); } while (0)
#define CONV_BLOCK(DO0, DO1) do { CONV_STEP(0, DO0, DO1); CONV_STEP(1, DO0, DO1); CONV_STEP(2, DO0, DO1); CONV_STEP(3, DO0, DO1); CONV_STEP(4, DO0, DO1); CONV_STEP(5, DO0, DO1); CONV_STEP(6, DO0, DO1); CONV_STEP(7, DO0, DO1); } while (0)
#pragma unroll
    for (int k = 0; k < DA; ++k) CONV_LOADA(E0 + k, k);
    { unsigned zz_ = 0u; asm volatile("" : "+v"(zz_));
#pragma unroll
      for (int k = 0; k < W; ++k) F1[k] = (u32x4){zz_, zz_, zz_, zz_}; }
    for (int e = E0; e < E1; e += 8) CONV_BLOCK(false, true);
    { unsigned zz_ = 0u; asm volatile("" : "+v"(zz_));
#pragma unroll
      for (int k = 0; k < W; ++k) F0[k] = (u32x4){zz_, zz_, zz_, zz_}; }
    for (int e = E1; e < E2; e += 8) CONV_BLOCK(true, true);
    for (int e = E2; e < E3; e += 8) CONV_BLOCK(true, false);
#undef CONV_BLOCK
#undef CONV_STEP
#undef CONV_MM
#undef CONV_LDF
#undef CONV_LOADA
    __syncthreads();
    int lane2; { unsigned ones_ = ~0u; asm volatile("" : "+s"(ones_)); lane2 = (int)__builtin_amdgcn_mbcnt_hi(ones_, __builtin_amdgcn_mbcnt_lo(ones_, 0u)); }
    const int nn2 = lane2 & 15, kq2 = lane2 >> 4;
    float nsum = 0.f;
    { const float* kq_ = (const float*)(ws + WS_KPART) + ((size_t)ib * 320 + (PROMPT ? 0 : 256)) * 2048; constexpr int ntile = PROMPT ? 256 : 64;
      for (int q = lane2; q < ntile; q += 64) nsum += kq_[(size_t)q * 2048 + c] + kq_[(size_t)q * 2048 + 1024 + c];
      nsum = wave_sum(nsum); }
    const float inv = 1.0f / nsum;
    LAS float* stage = (LAS float*)lds;
    const int tid2 = wave * 64 + lane2;
    const float* dbias = ka->in[I_HD] + ib * 1024 + c0;
    const bf16* X0B = (const bf16*)(ws + WS_X0); const bf16* VVB = (const bf16*)(ws + WS_VV); bf16* AMIX = (bf16*)(ws + WS_AMIX);
#pragma unroll
    for (int h = 0; h < 2; ++h) {
        if (HALF != 2 && h != HALF) continue;
#pragma unroll
        for (int rp = 0; rp < 4; ++rp)
#pragma unroll
            for (int r0 = 0; r0 < 2; ++r0)
#pragma unroll
                for (int gg = 0; gg < 2; ++gg)
#pragma unroll
                    for (int j = 0; j < 4; ++j) { const int tl = 32 * rp + 2 * (4 * kq2 + j) + r0; stage[wave * 4096 + tl * 32 + 16 * gg + nn2] = acc[r0][(HALF == 2 ? 4 * h : 0) + rp][gg][j] * inv; }
        __syncthreads();
        float db[8];
#pragma unroll
        for (int q = 0; q < 8; ++q) db[q] = dbias[q];
#pragma unroll 2
        for (int k = 0; k < 8; ++k) { const int row = tid2 + 512 * k, n = row & 31, tl = row >> 5;
            int t; if (PROMPT) t = 256 * n + 128 * h + tl; else t = TP + (4 * g + (n & 3)) * LS + 256 * (n >> 2) + 128 * h + tl;
            float y[8];
#pragma unroll
            for (int q = 0; q < 8; ++q) y[q] = stage[q * 4096 + row];
            const u32x4 xv = *(const u32x4*)(X0B + (size_t)t * 1024 + c0), vv = *(const u32x4*)(VVB + (size_t)t * 1024 + c0);
            u32x4 o;
            o.x = pk2((y[0] + bflo(vv.x) * db[0]) * bflo(xv.x), (y[1] + bfhi(vv.x) * db[1]) * bfhi(xv.x));
            o.y = pk2((y[2] + bflo(vv.y) * db[2]) * bflo(xv.y), (y[3] + bfhi(vv.y) * db[3]) * bfhi(xv.y));
            o.z = pk2((y[4] + bflo(vv.z) * db[4]) * bflo(xv.z), (y[5] + bfhi(vv.z) * db[5]) * bfhi(xv.z));
            o.w = pk2((y[6] + bflo(vv.w) * db[6]) * bflo(xv.w), (y[7] + bfhi(vv.w) * db[7]) * bfhi(xv.w));
            *(u32x4*)(AMIX + (size_t)t * D + 1024 + c0) = o; }
        __syncthreads();
    }
}

__device__ __forceinline__ void seq_of(int t, int& s0, int& L) { if (t < TP) { s0 = 0; L = TP; } else { s0 = TP + ((t - TP) / LS) * LS; L = LS; } }

__global__ void __launch_bounds__(512, 2) fwd_kernel(Args args) {
    extern __shared__ __attribute__((aligned(16))) unsigned char lds_raw[];
    LAS unsigned char* lds = (LAS unsigned char*)lds_raw;
    const int tid0 = threadIdx.x; const int wave0 = __builtin_amdgcn_readfirstlane(tid0 >> 6);
    const int G = gridDim.x, NGW = G * 8;
#define PHASE_IDS unsigned ones_ = ~0u; asm volatile("" : "+s"(ones_)); const int lane = (int)__builtin_amdgcn_mbcnt_hi(ones_, __builtin_amdgcn_mbcnt_lo(ones_, 0u)); const int wave = wave0, tid = wave * 64 + lane, gw = blockIdx.x * 8 + wave; (void)tid; (void)lane; (void)gw; KArgs ka = (KArgs)__builtin_amdgcn_kernarg_segment_ptr(); asm volatile("" : "+s"(ka)); unsigned char* const ws = ka->ws; (void)ws; \
    bf16* const XB = (bf16*)(ws + WS_XB); bf16* const HB = (bf16*)(ws + WS_H); bf16* const AMIX = (bf16*)(ws + WS_AMIX); bf16* const PB = (bf16*)(ws + WS_P); bf16* const X0B = (bf16*)(ws + WS_X0); bf16* const VVB = (bf16*)(ws + WS_VV); \
    float* const PART = (float*)(ws + WS_PART); float* const OUT = ka->out; (void)XB; (void)HB; (void)AMIX; (void)PB; (void)X0B; (void)VVB; (void)PART; (void)OUT;
    unsigned char* ws0 = args.ws;
    volatile LAS unsigned* MISC = (volatile LAS unsigned*)(lds + MISC_OFF);
    if (tid0 < 64) MISC[tid0] = 0u;
    __syncthreads();
    XcdBarrier bar; bar.bar = (unsigned*)(ws0 + WS_CTL) + 4096; bar.x = 0; bar.st = MISC + 8;
#if !MK_PER_PHASE
    bar = xcd_barrier_post((unsigned*)(ws0 + WS_CTL) + 4096, MISC + 8);
#endif
    const int lo = args.ph_lo, hi = args.ph_hi;
#define RUN(k) (lo <= (k) && (k) < hi)
#if MK_PER_PHASE
#define SEAM(k) do { } while (0)
#else
#define SEAM(k) do { if (RUN(k) && RUN((k) + 1)) xcd_barrier(bar); } while (0)
#endif
    int ph = 0;

    if (RUN(ph)) { PHASE_IDS
        for (int step = 0; step < 2; ++step) {
            if ((step == 0) != ((blockIdx.x & 1) != 0)) {
                for (int jb = blockIdx.x; jb < 640; jb += G) filter_job(ka, jb, (LAS float*)lds, tid);
            } else {
        for (int m = gw; m < T; m += NGW) {
            const float* xr = (m < TP) ? ka->in[I_XP] + (size_t)m * D : ka->in[I_XS] + (size_t)(m - TP) * D;
            const f32x4* x4 = (const f32x4*)xr + lane; float ss = 0.f; u32x2* o = (u32x2*)(XB + (size_t)m * D) + lane;
#pragma unroll
            for (int j = 0; j < 8; ++j) { const f32x4 v = x4[64 * j]; ss += (v[0] * v[0] + v[1] * v[1]) + (v[2] * v[2] + v[3] * v[3]); o[64 * j] = (u32x2){pk2(v[0], v[1]), pk2(v[2], v[3])}; }
            ss = wave_sum(ss);
            if (lane < 32) PART[(size_t)m * 32 + lane] = lane == 0 ? ss : 0.f;
        }
        cvt_slot(ka, 0, gw, NGW, lane);
            }
        }
    }
    SEAM(ph); ++ph;

    for (int l = 0; l < 4; ++l) {
        const int ib = l >> 1;
        for (int f = 0; f < 3; ++f) {
            if (f != 1) {
                if (RUN(ph)) { PHASE_IDS
                    unsigned char* fw = ws + WS_W + (size_t)(l * 2 + (f >> 1)) * SZ_FFN; pg8::Gemm g{XB, (const bf16*)fw, T, 2 * DFF, D, D, D, 0}; pg8::StaticOrder S; S.init(T, 2 * DFF, G, (int)blockIdx.x);
                    pg8::EpiSwiGLU E{HB, PART};
                    pg8::gemm_phase<pg8::EpiSwiGLU, true>(lds, g, S, E, tid);
                }
                SEAM(ph); ++ph;
                if (RUN(ph)) { PHASE_IDS
                    unsigned char* fw = ws + WS_W + (size_t)(l * 2 + (f >> 1)) * SZ_FFN; pg8::Gemm g{HB, (const bf16*)(fw + SZ_WI), T, D, DFF, 64, DFF, 0, 256 * 64 * 2}; pg8::StaticOrder S; S.init(T, D, G, (int)blockIdx.x, 1);
                    pg8::EpiResid E{XB, PART, 0.5f};
                    pg8::gemm_phase<pg8::EpiResid, true>(lds, g, S, E, tid);
                }
                SEAM(ph); ++ph;
            } else {
                const bool even = (l & 1) == 0;
                if (RUN(ph)) { PHASE_IDS
                    const int N = even ? ABIN : QKV; unsigned char* mixw = ws + WS_WMIX + (size_t)ib * SZ_MIX;
                    pg8::Gemm g{XB, (const bf16*)(even ? mixw : mixw + SZ_ABIN + SZ_DD + SZ_POOL), T, N, D, D, D, 0}; pg8::StaticOrder S; S.init(T, N, G, (int)blockIdx.x);
                    pg8::EpiScale E{HB, N, PART};
                    pg8::gemm_phase<pg8::EpiScale, true>(lds, g, S, E, tid);
                }
                SEAM(ph); ++ph;
                if (even) {
                    if (RUN(ph)) { PHASE_IDS
                        { const bf16* KT0 = (const bf16*)(ws + WS_KT + (size_t)ib * SZ_KT1); bf16* R0 = (bf16*)(ws + WS_R);
                          for (int tile = blockIdx.x; tile < 5120; tile += G) {
                              if (tile < 4096) r_transpose_tile(KT0, R0, TP, tile, (LAS unsigned short*)lds, tid);
                              else r_transpose_tile(KT0 + (size_t)2 * TP * 1024, R0 + (size_t)2 * TP * 1024, LS, tile - 4096, (LAS unsigned short*)lds, tid); } }
                        const float* cw = ka->in[I_HCW] + (size_t)ib * 3 * 3072; const float* cb = ka->in[I_HCB] + (size_t)ib * 3072;
                        bf16* VVT = (bf16*)(ws + WS_VVT);
                        LAS unsigned* vvl = (LAS unsigned*)lds;
                        for (int tile = blockIdx.x; tile < T / 32; tile += G) {
                          const int tok0 = tile * 32; int s0, L; seq_of(tok0, s0, L);
                          {
                            const int gq = wave & 3, th = wave >> 2, ck = gq * 32 + (lane & 31), c = ck * 8, tlocA = 16 * th + 8 * (lane >> 5), tA = tok0 + tlocA, tlA = tA - s0;
                            const u32x4 z = (u32x4){0u, 0u, 0u, 0u};
                            { const int hw = 1 << gq; float S[8] = {0, 0, 0, 0, 0, 0, 0, 0};
                              const bf16* ua = HB + (size_t)s0 * ABIN + c;
#define PREP_ROW(r) (((r) >= 0 && (r) < L) ? *(const u32x4*)(ua + (size_t)(r) * ABIN) : z)
#define PREP_ACC(S, v, sg) do { S[0] += sg bflo(v.x); S[1] += sg bfhi(v.x); S[2] += sg bflo(v.y); S[3] += sg bfhi(v.y); S[4] += sg bflo(v.z); S[5] += sg bfhi(v.z); S[6] += sg bflo(v.w); S[7] += sg bfhi(v.w); } while (0)
                              u32x4 vc[8], vin[7], vout[7];
#pragma unroll
                              for (int j = 0; j < 8; ++j) vc[j] = *(const u32x4*)(ua + (size_t)(tlA + j) * ABIN);
#pragma unroll
                              for (int j = 0; j < 7; ++j) { vin[j] = PREP_ROW(tlA + j + hw); vout[j] = PREP_ROW(tlA + j - hw); }
                              for (int q = 0; q < 2 * hw; ++q) { const u32x4 v = PREP_ROW(tlA - hw + q); PREP_ACC(S, v, +); }
#pragma unroll
                              for (int j = 0; j < 8; ++j) { const int tl = tlA + j; const int lo_ = max(tl - hw, 0), hi_ = min(tl + hw, L); const float inv = 1.0f / (float)(hi_ - lo_);
                                  const u32x4 v = vc[j];
                                  u32x4 o; o.x = pk2(S[0] * inv - bflo(v.x), S[1] * inv - bfhi(v.x)); o.y = pk2(S[2] * inv - bflo(v.y), S[3] * inv - bfhi(v.y));
                                  o.z = pk2(S[4] * inv - bflo(v.z), S[5] * inv - bfhi(v.z)); o.w = pk2(S[6] * inv - bflo(v.w), S[7] * inv - bfhi(v.w));
                                  *(u32x4*)(PB + (size_t)(s0 + tl) * 1024 + c) = o;
                                  if (j < 7) { const u32x4 va = vin[j], vs_ = vout[j]; PREP_ACC(S, va, +); PREP_ACC(S, vs_, -); } }
#undef PREP_ACC
#undef PREP_ROW
                            }
                            float x1k[8][8];
#pragma unroll
                            for (int comp = 0; comp < 3; ++comp) { const int cc = comp * 1024 + c; const bf16* ub = HB + (size_t)s0 * ABIN + 1024 + cc;
                                float w0[8], w1[8], w2[8], bb[8];
#pragma unroll
                                for (int e = 0; e < 8; e += 4) { const f32x4 a0 = *(const f32x4*)(cw + cc + e), a1 = *(const f32x4*)(cw + 3072 + cc + e), a2 = *(const f32x4*)(cw + 6144 + cc + e), a3 = *(const f32x4*)(cb + cc + e);
#pragma unroll
                                    for (int x = 0; x < 4; ++x) { w0[e + x] = a0[x]; w1[e + x] = a1[x]; w2[e + x] = a2[x]; bb[e + x] = a3[x]; } }
                                u32x4 rows[10];
#pragma unroll
                                for (int q = 0; q < 10; ++q) { const int r = tlA - 1 + q; rows[q] = (r >= 0 && r < L) ? *(const u32x4*)(ub + (size_t)r * ABIN) : z; }
#pragma unroll
                                for (int j = 0; j < 8; ++j) { float uc[8];
                                    const unsigned am[4] = {rows[j].x, rows[j].y, rows[j].z, rows[j].w}, a0[4] = {rows[j + 1].x, rows[j + 1].y, rows[j + 1].z, rows[j + 1].w}, ap[4] = {rows[j + 2].x, rows[j + 2].y, rows[j + 2].z, rows[j + 2].w};
#pragma unroll
                                    for (int e = 0; e < 8; ++e) { const float xm = (e & 1) ? bfhi(am[e >> 1]) : bflo(am[e >> 1]), x0 = (e & 1) ? bfhi(a0[e >> 1]) : bflo(a0[e >> 1]), xp = (e & 1) ? bfhi(ap[e >> 1]) : bflo(ap[e >> 1]);
                                        uc[e] = xm * w0[e] + x0 * w1[e] + xp * w2[e] + bb[e]; }
                                    const size_t orow = (size_t)(tA + j) * 1024 + c;
                                    if (comp == 0) { u32x4 o; o.x = pk2(uc[0], uc[1]); o.y = pk2(uc[2], uc[3]); o.z = pk2(uc[4], uc[5]); o.w = pk2(uc[6], uc[7]); *(u32x4*)(X0B + orow) = o; }
                                    else if (comp == 1) {
#pragma unroll
                                        for (int e = 0; e < 8; ++e) x1k[j][e] = uc[e]; }
                                    else { u32x4 o; o.x = pk2(uc[0] * x1k[j][0], uc[1] * x1k[j][1]); o.y = pk2(uc[2] * x1k[j][2], uc[3] * x1k[j][3]); o.z = pk2(uc[4] * x1k[j][4], uc[5] * x1k[j][5]); o.w = pk2(uc[6] * x1k[j][6], uc[7] * x1k[j][7]);
                                        *(u32x4*)(VVB + orow) = o; LAS unsigned* dl = vvl + (tlocA + j) * 513 + ck * 4; dl[0] = o.x; dl[1] = o.y; dl[2] = o.z; dl[3] = o.w; } } }
                          }
                          __syncthreads();
                          { int l2_ = lane; asm volatile("" : "+v"(l2_)); const LAS unsigned short* vs = (const LAS unsigned short*)vvl; const int tt = l2_ & 31, cp = l2_ >> 5;
                            for (int k = 0; k < 64; ++k) { const int c = 2 * (wave * 64 + k) + cp; VVT[(size_t)c * T + tok0 + tt] = vs[tt * 1026 + c]; } }
                          __syncthreads();
                        }
                    }
                    SEAM(ph); ++ph;
                    if (RUN(ph)) {
                        { PHASE_IDS
                        { unsigned char* mixw = ws + WS_WMIX + (size_t)ib * SZ_MIX; pg8::Gemm g{PB, (const bf16*)(mixw + SZ_ABIN + SZ_DD), T, 1024, 256, 1024, 256, 512}; pg8::StaticOrder S; S.init(T, 1024, G, (int)blockIdx.x);
                          pg8::EpiColScale E{AMIX, D, ka->in[I_POOLS] + ib * 1024};
                          pg8::gemm_phase<pg8::EpiColScale, true>(lds, g, S, E, tid); }
                        }
                        { PHASE_IDS
                        for (int it = (int)blockIdx.x; it < 512; it += G) {
                            if (it < 256) { if (it & 1) conv_item<true, 1>(ws, ka, ib, it >> 1, 0, lds, tid, lane, wave); else conv_item<true, 0>(ws, ka, ib, it >> 1, 0, lds, tid, lane, wave); }
                            else conv_item<false, 2>(ws, ka, ib, (it - 256) >> 1, (it - 256) & 1, lds, tid, lane, wave); }
                        }
                    }
                    SEAM(ph); ++ph;
                } else {
                    if (RUN(ph)) { PHASE_IDS
                        int tab_key = -1;
                        for (int u = blockIdx.x; u < 1536; u += G) att::attn_unit(HB, AMIX, ka->in[I_SINK] + ib * 16, ka->in[I_RELB], u, lds, tid, lane, wave, tab_key);
                    }
                    SEAM(ph); ++ph;
                }
                if (RUN(ph)) { PHASE_IDS
                    unsigned char* mixw = ws + WS_WMIX + (size_t)ib * SZ_MIX; pg8::Gemm g{AMIX, (const bf16*)(even ? mixw + SZ_ABIN : mixw + SZ_ABIN + SZ_DD + SZ_POOL + SZ_QKV), T, D, D, D, D, 0}; pg8::StaticOrder S; S.init(T, D, G, (int)blockIdx.x, 1);
                    pg8::EpiResid E{XB, PART, 1.0f};
                    pg8::gemm_phase<pg8::EpiResid, true>(lds, g, S, E, tid);
                }
                SEAM(ph); ++ph;
            }
        }
    }
    if (RUN(ph)) { PHASE_IDS
        const float* gn = ka->in[I_NFIN];
        for (int m = gw; m < T; m += NGW) {
            float s = lane < 32 ? PART[(size_t)m * 32 + lane] : 0.f; s = wave_sum(s); const float rs = 1.0f / sqrtf(s * (1.0f / D) + EPS);
            f32x4* x4 = (f32x4*)(OUT + (size_t)m * D) + lane; const f32x4* g4 = (const f32x4*)gn + lane; const u32x2* xb2 = (const u32x2*)(XB + (size_t)m * D) + lane;
#pragma unroll
            for (int j = 0; j < 8; ++j) { const u32x2 xw = xb2[64 * j]; const f32x4 v = (f32x4){bflo(xw.x), bfhi(xw.x), bflo(xw.y), bfhi(xw.y)}, gg = g4[64 * j]; x4[64 * j] = v * rs * gg; }
        }
    }
#undef RUN
#undef SEAM
}

extern "C" void kernel_launch(void* const* d_in, const int* in_sizes, int n_in, void* d_out, int out_size, void* d_ws, size_t ws_size, hipStream_t stream) {
    static int grid = 0;
    if (grid == 0) {
        if (n_in != 30 || out_size != T * D || ws_size < WS_END) { fprintf(stderr, "kernel_launch: unexpected shapes (n_in %d, out %d, ws %zu < %zu)\n", n_in, out_size, ws_size, (size_t)WS_END); grid = -1; return; }
        int dev = 0, cus = 0, per_cu = 0;
        if (hipGetDevice(&dev) != hipSuccess || hipDeviceGetAttribute(&cus, hipDeviceAttributeMultiprocessorCount, dev) != hipSuccess) { grid = -1; return; }
        if (hipFuncSetAttribute((const void*)fwd_kernel, hipFuncAttributeMaxDynamicSharedMemorySize, LDS_BYTES) != hipSuccess) { fprintf(stderr, "kernel_launch: hipFuncSetAttribute failed\n"); grid = -1; return; }
        if (hipOccupancyMaxActiveBlocksPerMultiprocessor(&per_cu, (const void*)fwd_kernel, 512, LDS_BYTES) != hipSuccess || per_cu < 1) { fprintf(stderr, "kernel_launch: occupancy query reports %d\n", per_cu); }
        (void)hipGetLastError();
        grid = cus;
    }
    if (grid < 0) return;
    (void)hipMemsetAsync((char*)d_ws + WS_CTL, 0, CTL_BYTES, stream);
    Args a{};
    for (int i = 0; i < 30; ++i) a.in[i] = (const float*)d_in[i];
    a.out = (float*)d_out; a.ws = (unsigned char*)d_ws;
#if MK_PER_PHASE
    for (int p = 0; p < NPHASES; ++p) { a.ph_lo = p; a.ph_hi = p + 1; hipLaunchKernelGGL(fwd_kernel, dim3(grid), dim3(512), LDS_BYTES, stream, a); }
#else
    a.ph_lo = 0; a.ph_hi = NPHASES;
    hipLaunchKernelGGL(fwd_kernel, dim3(grid), dim3(512), LDS_BYTES, stream, a);
#endif
}
```

```cpp
#include <hip/hip_runtime.h>
#include <cstdio>
#include <cstdint>

#ifndef MK_PER_PHASE
#define MK_PER_PHASE 0
#endif

#define LAS __attribute__((address_space(3)))
#define GAS __attribute__((address_space(1)))
typedef unsigned short bf16;
typedef short bf16x8 __attribute__((ext_vector_type(8)));
typedef float f32x4 __attribute__((ext_vector_type(4)));
typedef float f32x2 __attribute__((ext_vector_type(2)));
typedef unsigned u32x4 __attribute__((ext_vector_type(4)));
typedef unsigned u32x2 __attribute__((ext_vector_type(2)));
typedef float f32x16 __attribute__((ext_vector_type(16)));

constexpr int D = 2048, DFF = 5632, T = 24576, TP = 8192, LS = 2048, NSEQ_S = 8;
constexpr int NH = 16, NKV = 4, HD = 128, QKV = 3072, ABIN = 4096, PW = 1024, HW = 1024;
constexpr float EPS = 1e-6f;
constexpr int NPHASES = 32;

constexpr size_t SZ_WI = (size_t)2 * DFF * D * 2, SZ_WO = (size_t)D * DFF * 2;
constexpr size_t SZ_FFN = SZ_WI + SZ_WO;
constexpr size_t SZ_ABIN = (size_t)ABIN * D * 2, SZ_DD = (size_t)D * D * 2, SZ_POOL = (size_t)1024 * 256 * 2, SZ_QKV = (size_t)QKV * D * 2;
constexpr size_t SZ_MIX = SZ_ABIN + SZ_DD + SZ_POOL + SZ_QKV + SZ_DD;
constexpr size_t WS_CTL = 0, CTL_BYTES = 1u << 20;
constexpr size_t WS_W = CTL_BYTES;
constexpr size_t WS_WMIX = WS_W + 8 * SZ_FFN;
constexpr size_t WS_XB = WS_WMIX + 2 * SZ_MIX;
constexpr size_t WS_H = WS_XB + (size_t)T * D * 2;
constexpr size_t WS_AMIX = WS_H + (size_t)T * DFF * 2;
constexpr size_t WS_P = WS_AMIX + (size_t)T * D * 2;
constexpr size_t WS_X0 = WS_P + (size_t)T * 1024 * 2;
constexpr size_t WS_VV = WS_X0 + (size_t)T * 1024 * 2;
constexpr size_t SZ_KT1 = (size_t)(2 * TP + 2 * LS) * 1024 * 2;
constexpr size_t WS_KT = WS_VV + (size_t)T * 1024 * 2;
constexpr size_t WS_PART = WS_KT + 2 * SZ_KT1;
constexpr size_t WS_KPART = WS_PART + (size_t)T * 32 * 4;
constexpr size_t WS_R = WS_KPART + (size_t)2 * 320 * 2048 * 4;
constexpr size_t WS_END = WS_R + (size_t)(2 * TP + 2 * LS) * 1024 * 2;
constexpr size_t WS_VVT = WS_H + (size_t)T * ABIN * 2;
static_assert(WS_VVT + (size_t)T * 1024 * 2 <= WS_AMIX, "VVT must fit behind U in the H region");
static_assert(WS_END <= 1476395008ull, "workspace map exceeds 4x largest input");

constexpr int RING_BYTES = 131072, LDS_BYTES = 147456, MISC_OFF = LDS_BYTES - 256;

#define LDS_WAIT() asm volatile("s_waitcnt lgkmcnt(0)" ::: "memory")
#define VM_WAIT() asm volatile("s_waitcnt vmcnt(0)" ::: "memory")
__device__ __forceinline__ unsigned f2bf(float f) { unsigned u = __builtin_bit_cast(unsigned, f); return (u + 0x7fffu + ((u >> 16) & 1u)) >> 16; }
__device__ __forceinline__ unsigned pk2(float lo, float hi) { return f2bf(lo) | (f2bf(hi) << 16); }
__device__ __forceinline__ unsigned cvt_pk_bf16(float lo, float hi) { unsigned r; asm volatile("v_cvt_pk_bf16_f32 %0, %1, %2" : "=v"(r) : "v"(lo), "v"(hi)); return r; }
__device__ __forceinline__ float bflo(unsigned w) { return __builtin_bit_cast(float, w << 16); }
__device__ __forceinline__ float bfhi(unsigned w) { return __builtin_bit_cast(float, w & 0xffff0000u); }
__device__ __forceinline__ float bf1(bf16 b) { return __builtin_bit_cast(float, (unsigned)b << 16); }
__device__ __forceinline__ float wave_sum(float v) {
#pragma unroll
    for (int o = 1; o < 64; o <<= 1) v += __shfl_xor(v, o);
    return v;
}
__device__ __forceinline__ float wave_max(float v) {
#pragma unroll
    for (int o = 1; o < 64; o <<= 1) v = fmaxf(v, __shfl_xor(v, o));
    return v;
}

#define XB_TMO      128
#define XB_XCNT(j)  (256  + 64 * (j))
#define XB_XSUB(j)  (1280 + 64 * (j))
#define XB_XGEN(j)  (2304 + 64 * (j))
#define XB_TOP      3328
#define XB_TOPGEN   3392
#define XCD_BAR_WORDS 3456
#define XB_SPIN_CAP (1u << 18)
__device__ __forceinline__ unsigned xb_ld(unsigned* p)              { return __hip_atomic_load(p, __ATOMIC_RELAXED, __HIP_MEMORY_SCOPE_AGENT); }
__device__ __forceinline__ unsigned xb_add(unsigned* p, unsigned v) { return __hip_atomic_fetch_add(p, v, __ATOMIC_RELAXED, __HIP_MEMORY_SCOPE_AGENT); }
__device__ __forceinline__ unsigned xb_xcc_id() { return (unsigned)__builtin_amdgcn_s_getreg((3 << 11) | 20) & 0xFu; }
#define XB_SPIN(cond, bar) do { unsigned _sp = 0; while (cond) { __builtin_amdgcn_s_sleep(1); \
    if ((++_sp & 255u) == 0u) { if (xb_ld(&(bar)[XB_TMO])) break; if (_sp > XB_SPIN_CAP) { atomicAdd(&(bar)[XB_TMO], 1u); break; } } } } while (0)
struct XcdBarrier { unsigned* bar; unsigned x; volatile LAS unsigned* st; };
__device__ __forceinline__ XcdBarrier xcd_barrier_post(unsigned* bar, volatile LAS unsigned* st) {
    XcdBarrier b; b.bar = bar; b.x = xb_xcc_id(); b.st = st;
    if (threadIdx.x == 0) (void)xb_add(&bar[XB_XCNT(b.x)], 1u);
    return b;
}
__device__ __forceinline__ void xcd_barrier_complete(unsigned* bar, unsigned x, unsigned& nloc, unsigned& nx) {
    const unsigned G = gridDim.x * gridDim.y * gridDim.z;
    unsigned sum, cnt, mine, sp = 0u;
    for (;;) {
        sum = 0u; cnt = 0u; mine = 0u;
#pragma unroll
        for (unsigned j = 0; j < 16; ++j) { const unsigned c = xb_ld(&bar[XB_XCNT(j)]); sum += c; cnt += (c > 0u) ? 1u : 0u; mine = (j == x) ? c : mine; }
        if (sum == G) break;
        __builtin_amdgcn_s_sleep(1);
        if ((++sp & 255u) == 0u) { if (xb_ld(&bar[XB_TMO])) break; if (sp > XB_SPIN_CAP) { atomicAdd(&bar[XB_TMO], 1u); break; } }
    }
    nloc = mine > 0u ? mine : 1u; nx = cnt > 0u ? cnt : 1u;
}
__device__ __forceinline__ void xcd_barrier(const XcdBarrier& b) {
    asm volatile("s_waitcnt vmcnt(0)" ::: "memory");
    __syncthreads();
    if (threadIdx.x == 0) {
        unsigned* bar = b.bar;
        __builtin_amdgcn_s_waitcnt(0);
        unsigned nloc = b.st[0], nx = b.st[1];
        if (nloc == 0u) { xcd_barrier_complete(bar, b.x, nloc, nx); b.st[0] = nloc; b.st[1] = nx; }
        const unsigned old = xb_add(&bar[XB_XSUB(b.x)], 1u);
        const unsigned gen = old / nloc;
        if (old + 1u == (gen + 1u) * nloc) {
            __builtin_amdgcn_fence(__ATOMIC_RELEASE, "agent");
            asm volatile("s_waitcnt vmcnt(0)" ::: "memory");
            const unsigned og = xb_add(&bar[XB_TOP], 1u);
            const unsigned tg = og / nx;
            if (og + 1u == (tg + 1u) * nx) xb_add(&bar[XB_TOPGEN], 1u);
            else XB_SPIN(xb_ld(&bar[XB_TOPGEN]) == tg, bar);
            __builtin_amdgcn_fence(__ATOMIC_ACQUIRE, "agent");
            xb_add(&bar[XB_XGEN(b.x)], 1u);
            asm volatile("s_waitcnt vmcnt(0)" ::: "memory");
        } else {
            XB_SPIN(xb_ld(&bar[XB_XGEN(b.x)]) == gen, bar);
            __builtin_amdgcn_fence(__ATOMIC_ACQUIRE, "agent");
            asm volatile("s_waitcnt vmcnt(0)" ::: "memory");
        }
    }
    __syncthreads();
}

namespace pg8 {
constexpr int BM = 256, BK = 64, HALF = 128, HTB = HALF * BK * 2, STAGE_BYTES = 8 * HTB, NXCD = 8, WGM = 8;
__host__ __device__ __forceinline__ int lds_byte(int r, int c) { const int st = (r >> 4) * 2 + (c >> 5), rr = r & 15, cc = c & 31, ob = rr * 64 + cc * 2; return st * 1024 + (ob ^ (((ob >> 9) & 1) << 5)); }
__host__ __device__ __forceinline__ void stage_rc(int b, int& R, int& C) { const int st = b / 1024, sb = b % 1024, swz = sb ^ (((sb >> 9) & 1) << 5); R = (st >> 1) * 16 + swz / 64; C = (st & 1) * 32 + (swz % 64) / 2; }
__host__ __device__ __forceinline__ int perm32(int rho) { const int n = rho >> 4, i = rho & 15; return 8 * (i >> 2) + 4 * n + (i & 3); }
struct Unit { int pm, pn; };
struct Gemm { const bf16* A; const bf16* Bt; int M, N, K, lda, ldb, acs; int ktA = 0, ktB = 0; };
struct StaticOrder {
    int nM, nN, nwg, G, c, wgm, rev;
    __device__ void init(int M, int N, int G_, int c_, int rev_ = 0) { nM = M / BM; nN = N / BM; nwg = nM * nN; G = G_; c = c_; wgm = (nN == 8) ? 4 : WGM; rev = rev_; }
    __device__ bool next(int i, Unit& u) const {
        const long L = (long)i * G + c; if (L >= nwg) return false;
        int wgid = (int)L; { const int q = nwg / NXCD, r = nwg % NXCD, xcd = wgid % NXCD, off = wgid / NXCD; wgid = (xcd < r ? xcd * (q + 1) : r * (q + 1) + (xcd - r) * q) + off; }
        const int nig = wgm * nN, gid = wgid / nig, fm = gid * wgm, gsz = (nM - fm) < wgm ? (nM - fm) : wgm;
        u.pm = fm + ((wgid % nig) % gsz); u.pn = (wgid % nig) / gsz; if (rev) u.pm = nM - 1 - u.pm; return true;
    }
};
template <class Epi, bool ALIGN_EPI>
__device__ __forceinline__ void gemm_phase(LAS unsigned char* lds, const Gemm g, const StaticOrder& S, const Epi& E, const int tid) {
    const int wid = __builtin_amdgcn_readfirstlane(tid >> 6), lane = tid & 63, wr = wid >> 2, wc = wid & 3, fr = lane & 15, fq = lane >> 4;
    const int K = g.K, nt = K / BK;
    unsigned voffA[2], voffB[2];
#pragma unroll
    for (int i = 0; i < 2; ++i) { int R, C; stage_rc(tid * 16 + i * 8192, R, C); const int Rb = (R & ~31) + perm32(R & 31);
        voffA[i] = (unsigned)(R * g.lda + C) * 2u; voffB[i] = (unsigned)(Rb * g.ldb + C) * 2u; }
    const size_t kstep = (size_t)(BK * 2), kstepA = g.ktA ? (size_t)g.ktA : kstep, kstepB = g.ktB ? (size_t)g.ktB : kstep;
    const size_t hstepA = (size_t)HALF * g.lda * 2, hstepB = (size_t)HALF * g.ldb * 2;
    const size_t tstepA = g.ktA ? (size_t)g.ktA * (size_t)nt : 2 * hstepA, tstepB = g.ktB ? (size_t)g.ktB * (size_t)nt : 2 * hstepB;
    const unsigned ldsw = (unsigned)wid * 1024u;
    const int aoff = lds_byte(wr * 64 + fr, fq * 8), boff = lds_byte(wc * 32 + fr, fq * 8);
#define PG8_SA(b, h) (((b) * 2 + (h)) * HTB)
#define PG8_SB(b, h) ((4 + (b) * 2 + (h)) * HTB)
#define PG8_STAGE(bufoff, gbase, voff) do { _Pragma("unroll") for (int _i = 0; _i < 2; ++_i) \
        __builtin_amdgcn_global_load_lds((const unsigned*)((const char*)(gbase) + (voff)[_i]), (LAS unsigned*)(lds + (bufoff) + ldsw + _i * 8192), 16, 0, 0); } while (0)
#define PG8_LDA(dst, b, h) do { _Pragma("unroll") for (int m = 0; m < 4; ++m) _Pragma("unroll") for (int k = 0; k < 2; ++k) dst[m][k] = *(const LAS bf16x8*)(lds + PG8_SA(b, h) + aoff + m * 2048 + k * 1024); } while (0)
#define PG8_LDB(dst, b, h) do { _Pragma("unroll") for (int n = 0; n < 2; ++n) _Pragma("unroll") for (int k = 0; k < 2; ++k) dst[n][k] = *(const LAS bf16x8*)(lds + PG8_SB(b, h) + boff + n * 2048 + k * 1024); } while (0)
#define PG8_MMA(ai, bj, At, Bt) do { __builtin_amdgcn_s_setprio(1); _Pragma("unroll") for (int m = 0; m < 4; ++m) _Pragma("unroll") for (int n = 0; n < 2; ++n) _Pragma("unroll") for (int k = 0; k < 2; ++k) \
        acc[ai][bj][m][n] = __builtin_amdgcn_mfma_f32_16x16x32_bf16(Bt[n][k], At[m][k], acc[ai][bj][m][n], 0, 0, 0); __builtin_amdgcn_s_setprio(0); } while (0)
#define PG8_WAIT_V(n) asm volatile("s_waitcnt vmcnt(" #n ")" ::: "memory")
#define PG8_WAIT_L(n) asm volatile("s_waitcnt lgkmcnt(" #n ")" ::: "memory")
#define PG8_BAR __builtin_amdgcn_s_barrier()
#define PG8_SCHED __builtin_amdgcn_sched_barrier(0)
    Unit cur, nxt; int ui = 0; int rs_pm = -1;
    if (!S.next(0, cur)) return;
    f32x4 acc[2][2][4][2];
#pragma unroll
    for (int a = 0; a < 2; ++a)
#pragma unroll
        for (int b = 0; b < 2; ++b)
#pragma unroll
            for (int m = 0; m < 4; ++m)
#pragma unroll
                for (int n = 0; n < 2; ++n) acc[a][b][m][n] = (f32x4){0.f, 0.f, 0.f, 0.f};
    bf16x8 At[4][2], B0[2][2], B1[2][2];
    const char* cA = (const char*)g.A + (size_t)cur.pm * tstepA + (size_t)cur.pn * g.acs; const char* cB = (const char*)g.Bt + (size_t)cur.pn * tstepB;
    PG8_STAGE(PG8_SB(0, 0), cB, voffB); PG8_STAGE(PG8_SB(0, 1), cB + hstepB, voffB); PG8_STAGE(PG8_SA(0, 0), cA, voffA); PG8_STAGE(PG8_SA(0, 1), cA + hstepA, voffA);
    if (wr == 1) PG8_BAR;
    PG8_WAIT_V(2); PG8_BAR;
    PG8_STAGE(PG8_SB(1, 0), cB + kstepB, voffB); PG8_STAGE(PG8_SA(1, 0), cA + kstepA, voffA); PG8_STAGE(PG8_SB(1, 1), cB + hstepB + kstepB, voffB);
    PG8_WAIT_V(6); PG8_BAR;
    for (;;) {
        const bool has_next = S.next(ui + 1, nxt);
        const char* nA = has_next ? (const char*)g.A + (size_t)nxt.pm * tstepA + (size_t)nxt.pn * g.acs : cA; const char* nB = has_next ? (const char*)g.Bt + (size_t)nxt.pn * tstepB : cB;
        for (int t = 0; t < nt; t += 2) {
            const bool last = (t == nt - 2);
            const char* a1 = cA + (size_t)(t + 1) * kstepA;
            const char* a2 = last ? nA : cA + (size_t)(t + 2) * kstepA; const char* b2 = last ? nB : cB + (size_t)(t + 2) * kstepB;
            const char* a3 = a2 + kstepA; const char* b3 = b2 + kstepB;
            PG8_LDB(B0, 0, 0); PG8_LDB(B1, 0, 1); PG8_SCHED; PG8_LDA(At, 0, 0); PG8_STAGE(PG8_SA(1, 1), a1 + hstepA, voffA);
            PG8_WAIT_V(8); PG8_WAIT_L(0); PG8_BAR; PG8_MMA(0, 0, At, B0); PG8_MMA(0, 1, At, B1); PG8_BAR; PG8_SCHED;
            PG8_LDA(At, 0, 1); PG8_STAGE(PG8_SB(0, 0), b2, voffB); PG8_STAGE(PG8_SB(0, 1), b2 + hstepB, voffB); PG8_STAGE(PG8_SA(0, 0), a2, voffA);
            PG8_WAIT_V(8); PG8_WAIT_L(0); PG8_BAR; PG8_MMA(1, 0, At, B0); PG8_MMA(1, 1, At, B1); PG8_BAR; PG8_SCHED;
            PG8_LDB(B0, 1, 0); PG8_LDB(B1, 1, 1); PG8_SCHED; PG8_LDA(At, 1, 0); PG8_STAGE(PG8_SA(0, 1), a2 + hstepA, voffA);
            PG8_WAIT_V(8); PG8_WAIT_L(0); PG8_BAR; PG8_MMA(0, 0, At, B0); PG8_MMA(0, 1, At, B1); PG8_BAR; PG8_SCHED;
            PG8_LDA(At, 1, 1); PG8_STAGE(PG8_SB(1, 0), b3, voffB); PG8_STAGE(PG8_SB(1, 1), b3 + hstepB, voffB); PG8_STAGE(PG8_SA(1, 0), a3, voffA);
            PG8_WAIT_V(8); PG8_WAIT_L(0); PG8_BAR; PG8_MMA(1, 0, At, B0); PG8_MMA(1, 1, At, B1); PG8_BAR; PG8_SCHED;
        }
        if constexpr (ALIGN_EPI) { if (wr == 0) PG8_BAR; }
        E(acc, cur, wr, wc, lds, rs_pm);
        if (!has_next) break;
        cur = nxt; cA = nA; cB = nB; ++ui;
        if constexpr (ALIGN_EPI) { if (wr == 1) PG8_BAR; }
    }
    PG8_WAIT_V(0);
    if constexpr (!ALIGN_EPI) { if (wr == 0) PG8_BAR; }
    PG8_BAR;
#undef PG8_SA
#undef PG8_SB
#undef PG8_STAGE
#undef PG8_LDA
#undef PG8_LDB
#undef PG8_MMA
#undef PG8_WAIT_V
#undef PG8_WAIT_L
#undef PG8_BAR
#undef PG8_SCHED
}

__device__ __forceinline__ u32x4 zero_frag() { unsigned z_ = 0u; asm volatile("" : "+v"(z_)); return (u32x4){z_, z_, z_, z_}; }
__device__ __forceinline__ void zero_acc(f32x4& a, u32x4& zb) { asm volatile("" : "+v"(zb));
    a = __builtin_amdgcn_mfma_f32_16x16x32_bf16(__builtin_bit_cast(bf16x8, zb), __builtin_bit_cast(bf16x8, zb), (f32x4){0.f, 0.f, 0.f, 0.f}, 0, 0, 0); }
__device__ __forceinline__ void epi_lane(int& fr, int& fq) { unsigned ones = ~0u; asm volatile("" : "+s"(ones)); const int ln = (int)__builtin_amdgcn_mbcnt_hi(ones, __builtin_amdgcn_mbcnt_lo(ones, 0u)); fr = ln & 15; fq = ln >> 4; }
__device__ __forceinline__ void load_rs(const float* part, int row0, int fq, float (&rs)[2][4]) {
#pragma unroll
    for (int ai = 0; ai < 2; ++ai)
#pragma unroll
        for (int m = 0; m < 4; ++m) {
            const f32x4* p = (const f32x4*)(part + (size_t)(row0 + ai * HALF + m * 16) * 32 + fq * 8);
            const f32x4 a = p[0], b = p[1];
            float s = ((a[0] + a[1]) + (a[2] + a[3])) + ((b[0] + b[1]) + (b[2] + b[3]));
            s += __shfl_xor(s, 16); s += __shfl_xor(s, 32);
            rs[ai][m] = __builtin_amdgcn_rsqf(s * (1.0f / D) + EPS);
        }
}
__device__ __forceinline__ void load_rs_cached(const float* part, int pm, int row0, int wid, int fr, int fq, LAS unsigned char* lds, int& rs_pm, float (&rs)[2][4]) {
    LAS float* rc = (LAS float*)(lds + RING_BYTES) + wid * 128 + fr;
    if (pm != rs_pm) {
        load_rs(part, row0, fq, rs); rs_pm = pm;
        if (fq == 0) {
#pragma unroll
            for (int q = 0; q < 8; ++q) rc[q * 16] = rs[q >> 2][q & 3]; }
    } else {
#pragma unroll
        for (int q = 0; q < 8; ++q) rs[q >> 2][q & 3] = rc[q * 16];
    }
}
struct EpiSwiGLU {
    bf16* H; const float* part;
    __device__ __forceinline__ void operator()(f32x4 (&acc)[2][2][4][2], const Unit& u, int wr, int wc, LAS unsigned char* lds, int& rs_pm) const {
        int fr, fq; epi_lane(fr, fq);
        const int row0 = u.pm * BM + wr * 64 + fr, col0 = u.pn * HALF + wc * 32 + 8 * fq;
        float rs[2][4]; load_rs_cached(part, u.pm, row0, wr * 4 + wc, fr, fq, lds, rs_pm, rs);
        u32x4 zb = zero_frag();
#pragma unroll
        for (int ai = 0; ai < 2; ++ai)
#pragma unroll
            for (int m = 0; m < 4; ++m) {
                const float r = rs[ai][m], rsn = r * -1.4426950408889634f, rs2 = r * r; float o[8];
                f32x4 av[2], gu[2];
#pragma unroll
                for (int n = 0; n < 2; ++n) { av[n] = acc[ai][0][m][n] * rsn; gu[n] = acc[ai][0][m][n] * acc[ai][1][m][n]; }
#pragma unroll
                for (int n = 0; n < 2; ++n) { zero_acc(acc[ai][0][m][n], zb); zero_acc(acc[ai][1][m][n], zb); }
#pragma unroll
                for (int n = 0; n < 2; ++n)
#pragma unroll
                    for (int j = 0; j < 4; ++j) av[n][j] = __builtin_amdgcn_exp2f(av[n][j]);
#pragma unroll
                for (int n = 0; n < 2; ++n) av[n] = av[n] + 1.0f;
#pragma unroll
                for (int n = 0; n < 2; ++n)
#pragma unroll
                    for (int j = 0; j < 4; ++j) av[n][j] = __builtin_amdgcn_rcpf(av[n][j]);
#pragma unroll
                for (int n = 0; n < 2; ++n) { const f32x4 q = gu[n] * (av[n] * rs2);
#pragma unroll
                    for (int j = 0; j < 4; ++j) o[n * 4 + j] = q[j]; }
                u32x4 w; w.x = cvt_pk_bf16(o[0], o[1]); w.y = cvt_pk_bf16(o[2], o[3]); w.z = cvt_pk_bf16(o[4], o[5]); w.w = cvt_pk_bf16(o[6], o[7]);
                *(u32x4*)(H + (((size_t)(u.pm * (DFF / 64) + u.pn * 2 + (wc >> 1)) * BM + (wr * 64 + fr + ai * HALF + m * 16)) * 64 + (wc & 1) * 32 + 8 * fq)) = w;
            }
    }
};
struct EpiScale {
    bf16* O; int ldc; const float* part;
    __device__ __forceinline__ void operator()(f32x4 (&acc)[2][2][4][2], const Unit& u, int wr, int wc, LAS unsigned char* lds, int& rs_pm) const {
        int fr, fq; epi_lane(fr, fq);
        const int row0 = u.pm * BM + wr * 64 + fr, col0 = u.pn * BM + wc * 32 + 8 * fq;
        float rs[2][4]; load_rs_cached(part, u.pm, row0, wr * 4 + wc, fr, fq, lds, rs_pm, rs);
        u32x4 zb = zero_frag();
#pragma unroll
        for (int ai = 0; ai < 2; ++ai)
#pragma unroll
            for (int m = 0; m < 4; ++m) { const float r = rs[ai][m]; bf16* rowp = O + (size_t)(row0 + ai * HALF + m * 16) * ldc + col0;
#pragma unroll
                for (int bj = 0; bj < 2; ++bj) { const f32x4 v0 = acc[ai][bj][m][0] * r, v1 = acc[ai][bj][m][1] * r; zero_acc(acc[ai][bj][m][0], zb); zero_acc(acc[ai][bj][m][1], zb);
                    u32x4 w; w.x = cvt_pk_bf16(v0[0], v0[1]); w.y = cvt_pk_bf16(v0[2], v0[3]); w.z = cvt_pk_bf16(v1[0], v1[1]); w.w = cvt_pk_bf16(v1[2], v1[3]);
                    *(u32x4*)(rowp + bj * HALF) = w; } }
    }
};
struct EpiColScale {
    bf16* O; int ldc; const float* cs;
    __device__ __forceinline__ void operator()(f32x4 (&acc)[2][2][4][2], const Unit& u, int wr, int wc, LAS unsigned char* lds, int& rs_pm) const {
        int fr, fq; epi_lane(fr, fq);
        const int row0 = u.pm * BM + wr * 64 + fr, col0 = u.pn * BM + wc * 32 + 8 * fq;
        f32x4 sv[2][2]; u32x4 zb = zero_frag();
#pragma unroll
        for (int bj = 0; bj < 2; ++bj)
#pragma unroll
            for (int n = 0; n < 2; ++n) sv[bj][n] = *(const f32x4*)(cs + col0 + bj * HALF + 4 * n);
#pragma unroll
        for (int ai = 0; ai < 2; ++ai)
#pragma unroll
            for (int m = 0; m < 4; ++m) { bf16* rowp = O + (size_t)(row0 + ai * HALF + m * 16) * ldc + col0;
#pragma unroll
                for (int bj = 0; bj < 2; ++bj) { const f32x4 v0 = acc[ai][bj][m][0] * sv[bj][0], v1 = acc[ai][bj][m][1] * sv[bj][1]; zero_acc(acc[ai][bj][m][0], zb); zero_acc(acc[ai][bj][m][1], zb);
                    u32x4 w; w.x = cvt_pk_bf16(v0[0], v0[1]); w.y = cvt_pk_bf16(v0[2], v0[3]); w.z = cvt_pk_bf16(v1[0], v1[1]); w.w = cvt_pk_bf16(v1[2], v1[3]);
                    *(u32x4*)(rowp + bj * HALF) = w; } }
    }
};
struct EpiResid {
    bf16* xb; float* part; float alpha;
    __device__ __forceinline__ void operator()(f32x4 (&acc)[2][2][4][2], const Unit& u, int wr, int wc, LAS unsigned char* lds, int& rs_pm) const {
        int fr, fq; epi_lane(fr, fq);
        const int row0 = u.pm * BM + wr * 64 + fr, col0 = u.pn * BM + wc * 32 + 8 * fq; u32x4 zb = zero_frag();
#pragma unroll
        for (int ai = 0; ai < 2; ++ai)
#pragma unroll
            for (int m = 0; m < 4; ++m) { const size_t oo = (size_t)(row0 + ai * HALF + m * 16) * D + col0; float ss = 0.f;
#pragma unroll
                for (int bj = 0; bj < 2; ++bj) {
                    const u32x4 xw = *(const u32x4*)(xb + oo + bj * HALF);
                    const f32x4 x0 = (f32x4){bflo(xw.x), bfhi(xw.x), bflo(xw.y), bfhi(xw.y)}, x1 = (f32x4){bflo(xw.z), bfhi(xw.z), bflo(xw.w), bfhi(xw.w)};
                    const f32x4 v0 = x0 + acc[ai][bj][m][0] * alpha, v1 = x1 + acc[ai][bj][m][1] * alpha; zero_acc(acc[ai][bj][m][0], zb); zero_acc(acc[ai][bj][m][1], zb);
                    ss += (v0[0] * v0[0] + v0[1] * v0[1]) + (v0[2] * v0[2] + v0[3] * v0[3]) + (v1[0] * v1[0] + v1[1] * v1[1]) + (v1[2] * v1[2] + v1[3] * v1[3]);
                    u32x4 w; w.x = cvt_pk_bf16(v0[0], v0[1]); w.y = cvt_pk_bf16(v0[2], v0[3]); w.z = cvt_pk_bf16(v1[0], v1[1]); w.w = cvt_pk_bf16(v1[2], v1[3]);
                    *(u32x4*)(xb + oo + bj * HALF) = w; }
                ss += __shfl_xor(ss, 16); ss += __shfl_xor(ss, 32);
                if (fq == 0) part[(size_t)(row0 + ai * HALF + m * 16) * 32 + u.pn * 4 + wc] = ss;
                asm volatile("" ::: "memory"); }
    }
};
}


namespace att {
typedef short s16x4 __attribute__((ext_vector_type(4)));
constexpr int SHM_V = 64 * 128 * 2, SHM_K = 64 * 128 * 2;
#define ATT_KSWZ(row, colB) ((row) * 256 + ((colB) ^ (((row) & 7) << 4)))
__device__ __forceinline__ int crow(int r, int hi) { return (r & 3) + 8 * (r >> 2) + 4 * hi; }
__device__ __forceinline__ int v_st(int k, int c) { const int kk = (k & ~0xC) | ((k & 4) << 1) | ((k & 8) >> 1); return ((kk >> 3) * 4 + (c >> 5)) * 512 + ((kk & 7) * 32 + (c & 31)) * 2; }
__device__ __forceinline__ int v_rd_base(int lane) { return ((lane & 3) << 3) | (((lane >> 2) & 3) << 6) | (((lane >> 4) & 1) << 5) | (((lane >> 5) & 1) << 8); }
constexpr int v_rd_off(int d0, int ks, int half) { return d0 * 512 + ks * 4096 + half * 2048; }
template <int OFF> __device__ __forceinline__ s16x4 tr_read(int vb) {
    s16x4 r; asm volatile("ds_read_b64_tr_b16 %0, %1 offset:%2" : "=&v"(r) : "v"(vb), "i"(OFF) : "memory"); return r;
}
template <int D0> __device__ __forceinline__ void pv_one(f32x16& od, int vb, bf16x8 pa0, bf16x8 pa1, bf16x8 pa2, bf16x8 pa3) {
    const s16x4 l0 = tr_read<v_rd_off(D0, 0, 0)>(vb), h0 = tr_read<v_rd_off(D0, 0, 1)>(vb), l1 = tr_read<v_rd_off(D0, 1, 0)>(vb), h1 = tr_read<v_rd_off(D0, 1, 1)>(vb);
    const s16x4 l2 = tr_read<v_rd_off(D0, 2, 0)>(vb), h2 = tr_read<v_rd_off(D0, 2, 1)>(vb), l3 = tr_read<v_rd_off(D0, 3, 0)>(vb), h3 = tr_read<v_rd_off(D0, 3, 1)>(vb);
    asm volatile("s_waitcnt lgkmcnt(0)" ::: "memory"); __builtin_amdgcn_sched_barrier(0);
#define ATT_PK(L, H) (bf16x8){L[0], L[1], L[2], L[3], H[0], H[1], H[2], H[3]}
    od = __builtin_amdgcn_mfma_f32_32x32x16_bf16(pa0, ATT_PK(l0, h0), od, 0, 0, 0);
    od = __builtin_amdgcn_mfma_f32_32x32x16_bf16(pa1, ATT_PK(l1, h1), od, 0, 0, 0);
    od = __builtin_amdgcn_mfma_f32_32x32x16_bf16(pa2, ATT_PK(l2, h2), od, 0, 0, 0);
    od = __builtin_amdgcn_mfma_f32_32x32x16_bf16(pa3, ATT_PK(l3, h3), od, 0, 0, 0);
#undef ATT_PK
}
__device__ __forceinline__ int t5_bucket(int rel) { const int n = rel < 0 ? -rel : rel; int bk = rel > 0 ? 16 : 0;
    if (n < 8) bk += n; else { const int lg = (31 - __builtin_clz((unsigned)(n * n))) - 6; bk += min(8 + lg, 15); } return bk; }

__device__ __forceinline__ void attn_unit(const bf16* QKVb, bf16* AMIXb, const float* sinkp, const float* relb, int u, LAS unsigned char* lds, int tid, int lane, int wave, int& tab_key) {
    asm volatile("" : "+v"(lane));
    const int gb = u >> 3, kv = (u >> 1) & 3, hp = u & 1;
    int s0, nblk, nb; if (gb < 64) { s0 = 0; nblk = 64; nb = gb; } else { const int r = gb - 64; s0 = TP + (r >> 4) * LS; nblk = 16; nb = r & 15; }
    const int r32 = lane & 31, hi = lane >> 5, hsel = wave >> 2, qa = wave & 3, head = kv * 4 + hp * 2 + hsel;
    const int q0 = s0 + nb * 128;
    LAS unsigned char* V_lds = lds; LAS unsigned char* K_lds = lds + 2 * SHM_V;
    LAS float* wsc = (LAS float*)(lds + 2 * SHM_V + 2 * SHM_K) + wave * 64; LAS float* tab = (LAS float*)(lds + 2 * SHM_V + 2 * SHM_K + 2048);
    constexpr float LOG2E = 1.4426950408889634f, C = 0.08838834764831845f * LOG2E;
    __syncthreads();
    if ((u & 7) != tab_key) { tab_key = u & 7;
    for (int e = tid; e < 1024; e += 512) { const int hs = e >> 9, idx = e & 511, rel = idx - 255; float v = -1e30f;
        if (rel >= -128 && rel <= 128) v = relb[t5_bucket(rel) * 16 + kv * 4 + hp * 2 + hs] * LOG2E;
        tab[e] = v; } }
    const bf16* Qw = QKVb + (size_t)(q0 + qa * 32 + r32) * QKV + head * 128 + hi * 8;
    bf16x8 qr[8];
#pragma unroll
    for (int d0 = 0; d0 < 8; ++d0) qr[d0] = *(const bf16x8*)(Qw + d0 * 16);
    const int jfirst = nb > 0 ? 0 : 2, jlast = nb < nblk - 1 ? 5 : 3;
    const bf16* Kg = QKVb + 2048 + kv * 128; const bf16* Vg = QKVb + 2560 + kv * 128;
    const int sr = tid >> 4, sc = (tid & 15) * 8, vst0 = v_st(sr, sc), vst1 = v_st(32 + sr, sc);
    const int vb0 = (int)(unsigned)(uintptr_t)V_lds + v_rd_base(lane);
    bf16x8 ks0, ks1, vs0, vs1;
#define ATT_TKEY(j) (q0 + ((j) >> 1) * 128 - 128 + ((j) & 1) * 64)
#define ATT_SLOAD(j) do { const size_t k0_ = (size_t)ATT_TKEY(j); ks0 = *(const bf16x8*)(Kg + (k0_ + sr) * QKV + sc); ks1 = *(const bf16x8*)(Kg + (k0_ + 32 + sr) * QKV + sc); \
        vs0 = *(const bf16x8*)(Vg + (k0_ + sr) * QKV + sc); vs1 = *(const bf16x8*)(Vg + (k0_ + 32 + sr) * QKV + sc); } while (0)
#define ATT_SWRITE(b) do { *(LAS bf16x8*)(V_lds + (b) * SHM_V + vst0) = vs0; *(LAS bf16x8*)(V_lds + (b) * SHM_V + vst1) = vs1; \
        *(LAS bf16x8*)(K_lds + (b) * SHM_K + ATT_KSWZ(sr, sc * 2)) = ks0; *(LAS bf16x8*)(K_lds + (b) * SHM_K + ATT_KSWZ(32 + sr, sc * 2)) = ks1; } while (0)
    const float sink2 = sinkp[head] * LOG2E;
    float m_reg = sink2, l_reg = 0.f;
    f32x16 o[4];
#pragma unroll
    for (int d = 0; d < 4; ++d)
#pragma unroll
        for (int r = 0; r < 16; ++r) o[d][r] = 0.f;
    ATT_SLOAD(jfirst); asm volatile("s_waitcnt vmcnt(0)" ::: "memory"); ATT_SWRITE(0); __syncthreads();
    for (int j = jfirst; j <= jlast; ++j) {
        const int b = (j - jfirst) & 1;
        if (j < jlast) ATT_SLOAD(j + 1);
        if (!((j == 0 && qa >= 2) || (j == 5 && qa < 2))) {
        f32x16 p0, p1;
#pragma unroll
        for (int r = 0; r < 16; ++r) { p0[r] = 0.f; p1[r] = 0.f; }
        { const LAS unsigned char* Ks = K_lds + b * SHM_K;
#pragma unroll
          for (int d0 = 0; d0 < 8; ++d0) { const int cb = (d0 * 16 + hi * 8) * 2;
              const bf16x8 b0 = *(const LAS bf16x8*)(Ks + ATT_KSWZ(r32, cb)), b1 = *(const LAS bf16x8*)(Ks + ATT_KSWZ(32 + r32, cb));
              p0 = __builtin_amdgcn_mfma_f32_32x32x16_bf16(b0, qr[d0], p0, 0, 0, 0);
              p1 = __builtin_amdgcn_mfma_f32_32x32x16_bf16(b1, qr[d0], p1, 0, 0, 0); } }
        { const int koff = ((j >> 1) - 1) * 128 + (j & 1) * 64;
          const LAS float* tb = tab + hsel * 512 + (koff - (qa * 32 + r32) + 255 + 4 * hi);
#pragma unroll
          for (int r = 0; r < 16; ++r) { p0[r] = fmaf(p0[r], C, tb[(r & 3) + 8 * (r >> 2)]); p1[r] = fmaf(p1[r], C, tb[32 + (r & 3) + 8 * (r >> 2)]); } }
        float pmax = p0[0];
#pragma unroll
        for (int r = 1; r < 16; ++r) pmax = fmaxf(pmax, p0[r]);
#pragma unroll
        for (int r = 0; r < 16; ++r) pmax = fmaxf(pmax, p1[r]);
        { auto rr = __builtin_amdgcn_permlane32_swap(__float_as_uint(pmax), __float_as_uint(pmax), false, false); pmax = fmaxf(__uint_as_float(rr[0]), __uint_as_float(rr[1])); }
        const float mn = fmaxf(m_reg, pmax), alpha = __builtin_amdgcn_exp2f(m_reg - mn); m_reg = mn;
        float ps = 0.f;
#pragma unroll
        for (int r = 0; r < 16; ++r) { p0[r] = __builtin_amdgcn_exp2f(p0[r] - mn); p1[r] = __builtin_amdgcn_exp2f(p1[r] - mn); ps += p0[r] + p1[r]; }
        { auto rr = __builtin_amdgcn_permlane32_swap(__float_as_uint(ps), __float_as_uint(ps), false, false); ps = __uint_as_float(rr[0]) + __uint_as_float(rr[1]); }
        l_reg = l_reg * alpha + ps;
        if (__any(alpha < 1.f)) { if (hi == 0) wsc[r32] = alpha; asm volatile("s_waitcnt lgkmcnt(0)" ::: "memory");
#pragma unroll
            for (int r = 0; r < 16; ++r) { const float al = wsc[crow(r, hi)];
#pragma unroll
                for (int d = 0; d < 4; ++d) o[d][r] *= al; }
            asm volatile("s_waitcnt lgkmcnt(0)" ::: "memory"); }
        bf16x8 pa0, pa1, pa2, pa3;
#define ATT_PK4(P, BASE, OUT) do { unsigned a0 = cvt_pk_bf16(P[BASE + 0], P[BASE + 1]), a1 = cvt_pk_bf16(P[BASE + 2], P[BASE + 3]);   \
        unsigned b0 = cvt_pk_bf16(P[BASE + 4], P[BASE + 5]), b1 = cvt_pk_bf16(P[BASE + 6], P[BASE + 7]);                              \
        auto r0 = __builtin_amdgcn_permlane32_swap(a0, b0, false, false); auto r1 = __builtin_amdgcn_permlane32_swap(a1, b1, false, false); \
        u32x4 w = {r0[0], r1[0], r0[1], r1[1]}; OUT = __builtin_bit_cast(bf16x8, w); } while (0)
        ATT_PK4(p0, 0, pa0); ATT_PK4(p0, 8, pa1); ATT_PK4(p1, 0, pa2); ATT_PK4(p1, 8, pa3);
#undef ATT_PK4
        { const int vb = vb0 + b * SHM_V;
          pv_one<0>(o[0], vb, pa0, pa1, pa2, pa3); pv_one<1>(o[1], vb, pa0, pa1, pa2, pa3); pv_one<2>(o[2], vb, pa0, pa1, pa2, pa3); pv_one<3>(o[3], vb, pa0, pa1, pa2, pa3); }
        }
        if (j < jlast) { asm volatile("s_waitcnt vmcnt(0)" ::: "memory"); ATT_SWRITE(b ^ 1); }
        __syncthreads();
    }
    l_reg += __builtin_amdgcn_exp2f(sink2 - m_reg);
    if (hi == 0) wsc[r32] = l_reg; asm volatile("s_waitcnt lgkmcnt(0)" ::: "memory");
    bf16* Ow = AMIXb + (size_t)(q0 + qa * 32) * D + head * 128 + r32;
#pragma unroll
    for (int r = 0; r < 16; ++r) { const int orow = crow(r, hi); const float rl = __builtin_amdgcn_rcpf(wsc[orow]);
#pragma unroll
        for (int d0 = 0; d0 < 4; ++d0) Ow[(size_t)orow * D + d0 * 32] = (bf16)f2bf(o[d0][r] * rl); }
    asm volatile("s_waitcnt lgkmcnt(0)" ::: "memory");
#undef ATT_TKEY
#undef ATT_SLOAD
#undef ATT_SWRITE
}
}

struct Args { const float* in[30]; float* out; unsigned char* ws; int ph_lo, ph_hi; };
typedef const Args __attribute__((address_space(4)))* KArgs;
enum { I_XP = 0, I_XS, I_NF1, I_F1WI, I_F1WO, I_NMIX, I_ABIN, I_POOLW, I_POOLS, I_HCW, I_HCB, I_HW1, I_HB1, I_HW2, I_HB2, I_HW3, I_HB3, I_HW4, I_HB4, I_HFREQ, I_HD,
       I_ABOUT, I_WQKV, I_WO, I_SINK, I_RELB, I_NF2, I_F2WI, I_F2WO, I_NFIN };

struct Mat { const float* src; const float* gain; bf16* dst; int K, N, srcN, swi, tiled; };
constexpr int NMAT = 34;
__device__ __forceinline__ Mat get_mat(KArgs a, int mi) {
    Mat m; m.gain = nullptr; m.swi = 0; m.tiled = 1;
    unsigned char* ws = a->ws;
    if (mi < 16) { const int l = mi >> 2, w = mi & 3; unsigned char* fb = ws + WS_W + (size_t)(l * 2 + (w >> 1)) * SZ_FFN;
        if ((w & 1) == 0) { m.src = a->in[(w >> 1) ? I_F2WI : I_F1WI] + (size_t)l * D * 2 * DFF; m.gain = a->in[(w >> 1) ? I_NF2 : I_NF1] + l * D; m.dst = (bf16*)fb; m.K = D; m.N = 2 * DFF; m.srcN = 2 * DFF; m.swi = 1; }
        else { m.src = a->in[(w >> 1) ? I_F2WO : I_F1WO] + (size_t)l * DFF * D; m.dst = (bf16*)(fb + SZ_WI); m.K = DFF; m.N = D; m.srcN = D; }
        return m; }
    mi -= 16;
    if (mi < 10) { const int i = mi / 5, w = mi % 5; unsigned char* mb = ws + WS_WMIX + (size_t)i * SZ_MIX;
        if (w == 0) { m.src = a->in[I_ABIN] + (size_t)i * D * ABIN; m.gain = a->in[I_NMIX] + (2 * i) * D; m.dst = (bf16*)mb; m.K = D; m.N = ABIN; m.srcN = ABIN; }
        else if (w == 1) { m.src = a->in[I_ABOUT] + (size_t)i * D * D; m.dst = (bf16*)(mb + SZ_ABIN); m.K = D; m.N = D; m.srcN = D; }
        else if (w == 2) { m.src = a->in[I_WQKV] + (size_t)i * D * QKV; m.gain = a->in[I_NMIX] + (2 * i + 1) * D; m.dst = (bf16*)(mb + SZ_ABIN + SZ_DD + SZ_POOL); m.K = D; m.N = QKV; m.srcN = QKV; }
        else if (w == 3) { m.src = a->in[I_WO] + (size_t)i * D * D; m.dst = (bf16*)(mb + SZ_ABIN + SZ_DD + SZ_POOL + SZ_QKV); m.K = D; m.N = D; m.srcN = D; }
        else { m.src = a->in[I_POOLW] + (size_t)i * 4 * 65536; m.dst = (bf16*)(mb + SZ_ABIN + SZ_DD); m.K = 256; m.N = 256; m.srcN = 256; m.tiled = 0; }
        return m; }
    mi -= 10;
    { const int i = mi / 3, gq = 1 + mi % 3; unsigned char* mb = ws + WS_WMIX + (size_t)i * SZ_MIX;
      m.src = a->in[I_POOLW] + (size_t)(i * 4 + gq) * 65536; m.dst = (bf16*)(mb + SZ_ABIN + SZ_DD) + (size_t)gq * 65536; m.K = 256; m.N = 256; m.srcN = 256; m.tiled = 0; }
    return m;
}
constexpr int NMAT_USED = 32;

__device__ __forceinline__ void cvt_item(const Mat& mt, int item, int lane) {
    const int nblk = mt.N / 64, kb = item / nblk, nb = item % nblk, k0 = 64 * kb, n0 = 64 * nb;
    int s0 = n0;
    if (mt.swi) { const int pn = n0 >> 8, half = (n0 >> 7) & 1, jj = n0 & 127; s0 = half * DFF + 128 * pn + jj; }
    const int kg = lane >> 4, nq = lane & 15;
    const float* src = mt.src + (size_t)(k0 + 16 * kg) * mt.srcN + s0 + 4 * nq;
    f32x4 v[16];
#pragma unroll
    for (int i = 0; i < 16; ++i) v[i] = *(const f32x4*)(src + (size_t)i * mt.srcN);
    if (mt.gain) { const f32x4* g4 = (const f32x4*)(mt.gain + k0 + 16 * kg);
#pragma unroll
        for (int q = 0; q < 4; ++q) { const f32x4 g = g4[q];
#pragma unroll
            for (int x = 0; x < 4; ++x) v[4 * q + x] = v[4 * q + x] * g[x]; } }
    const size_t rstep = mt.tiled ? (size_t)64 : (size_t)mt.K;
    bf16* dst = mt.tiled ? mt.dst + (((size_t)(nb >> 2) * (size_t)(mt.K / 64) + kb) * 256 + (nb & 3) * 64 + 4 * nq) * 64 + 16 * kg
                         : mt.dst + (size_t)(n0 + 4 * nq) * mt.K + k0 + 16 * kg;
#pragma unroll
    for (int e = 0; e < 4; ++e)
#pragma unroll
        for (int h = 0; h < 2; ++h) { u32x4 o;
            o.x = cvt_pk_bf16(v[8 * h + 0][e], v[8 * h + 1][e]); o.y = cvt_pk_bf16(v[8 * h + 2][e], v[8 * h + 3][e]);
            o.z = cvt_pk_bf16(v[8 * h + 4][e], v[8 * h + 5][e]); o.w = cvt_pk_bf16(v[8 * h + 6][e], v[8 * h + 7][e]);
            *(u32x4*)(dst + (size_t)e * rstep + 8 * h) = o; }
}


__device__ __forceinline__ int mat_slot(int mi) {
    return 0;
    if (mi < 16) { const int l = mi >> 2, w = mi & 3; return l == 0 ? 0 : (l == 1 ? 1 : (l == 2 ? (w < 2 ? 0 : 2) : 2)); }
    if (mi < 26) { const int i = (mi - 16) / 5, w = (mi - 16) % 5; if (i == 0) return (w == 2 || w == 3) ? 1 : 0; return w == 0 ? 0 : ((w == 1 || w == 4) ? 1 : 2); }
    return mi < 29 ? 0 : 1;
}
__device__ __forceinline__ void cvt_slot(KArgs ka, int slot, int wv, int nw, int lane) {
    int mi = -1; Mat mt; long base = 0; int cnt = 0;
    for (long it = wv; ; it += nw) {
        while (it >= base + cnt) { base += cnt; cnt = 0; do { ++mi; } while (mi < NMAT_USED && mat_slot(mi) != slot); if (mi >= NMAT_USED) break; mt = get_mat(ka, mi); cnt = (mt.K / 64) * (mt.N / 64); }
        if (mi >= NMAT_USED) break;
        cvt_item(mt, (int)(it - base), lane);
    }
}

__device__ __forceinline__ void filter_job(KArgs a, int jb, LAS float* sm, int tid) {
    const int i = jb / 320, r = jb % 320, lsel = r < 256 ? 0 : 1, tile = lsel ? r - 256 : r, L = lsel ? LS : TP, j0 = tile * 32;
    LAS float* zb = sm; LAS float* ha = sm + 32 * 36; LAS float* hb = ha + 32 * 64;
    const float* w1 = a->in[I_HW1] + i * 33 * 64; const float* b1 = a->in[I_HB1] + i * 64; const float* w2 = a->in[I_HW2] + i * 4096; const float* b2 = a->in[I_HB2] + i * 64;
    const float* w3 = a->in[I_HW3] + i * 4096; const float* b3 = a->in[I_HB3] + i * 64; const float* w4 = a->in[I_HW4] + (size_t)i * 64 * 2048; const float* b4 = a->in[I_HB4] + i * 2048;
    const float* fq = a->in[I_HFREQ] + i * 64;
    const int jj = tid >> 4, og = tid & 15;
    { const int j = j0 + jj; const float wj = 6.283185307179586f * (float)j / (float)L; const float fb = 1e-4f + (float)og * ((15.0f - 1e-4f) / 15.0f); const float ang = fb * wj;
      zb[jj * 36 + 1 + og] = cosf(ang); zb[jj * 36 + 17 + og] = -sinf(ang); if (og == 0) zb[jj * 36] = (float)j / (float)(L - 1); }
    __syncthreads();
    { float acc[4];
#pragma unroll
      for (int q = 0; q < 4; ++q) acc[q] = b1[og * 4 + q];
#pragma unroll 3
      for (int e = 0; e < 33; ++e) { const float z = zb[jj * 36 + e]; const f32x4 w = *(const f32x4*)(w1 + e * 64 + og * 4);
#pragma unroll
          for (int q = 0; q < 4; ++q) acc[q] += z * w[q]; }
#pragma unroll
      for (int q = 0; q < 4; ++q) ha[jj * 64 + og * 4 + q] = sinf(fq[og * 4 + q] * acc[q]); }
    __syncthreads();
    { float acc[4];
#pragma unroll
      for (int q = 0; q < 4; ++q) acc[q] = b2[og * 4 + q];
#pragma unroll 4
      for (int e = 0; e < 64; ++e) { const float z = ha[jj * 64 + e]; const f32x4 w = *(const f32x4*)(w2 + e * 64 + og * 4);
#pragma unroll
          for (int q = 0; q < 4; ++q) acc[q] += z * w[q]; }
#pragma unroll
      for (int q = 0; q < 4; ++q) hb[jj * 64 + og * 4 + q] = sinf(fq[og * 4 + q] * acc[q]); }
    __syncthreads();
    { float acc[4];
#pragma unroll
      for (int q = 0; q < 4; ++q) acc[q] = b3[og * 4 + q];
#pragma unroll 4
      for (int e = 0; e < 64; ++e) { const float z = hb[jj * 64 + e]; const f32x4 w = *(const f32x4*)(w3 + e * 64 + og * 4);
#pragma unroll
          for (int q = 0; q < 4; ++q) acc[q] += z * w[q]; }
#pragma unroll
      for (int q = 0; q < 4; ++q) ha[jj * 64 + og * 4 + q] = sinf(fq[og * 4 + q] * acc[q]); }
    __syncthreads();
    const int c4 = tid * 4, ch = c4 & 1023; const bool isb = c4 >= 1024;
    bf16* KT = (bf16*)(a->ws + WS_KT + (size_t)i * SZ_KT1 + (lsel ? (size_t)2 * TP * 1024 * 2 : 0));
    float* kp = (float*)(a->ws + WS_KPART) + ((size_t)i * 320 + r) * 2048;
    const float dmin = -3.0701134573253945f, dmax = -15.350567286626973f;
    float ad[4];
#pragma unroll
    for (int q = 0; q < 4; ++q) ad[q] = fabsf(dmin + (float)(ch + q) * ((dmax - dmin) / 1023.0f));
    const f32x4 bias = *(const f32x4*)(b4 + c4);
    float asum[4] = {0.f, 0.f, 0.f, 0.f};
    for (int grp = 0; grp < 4; ++grp) {
        float acc[8][4];
#pragma unroll
        for (int q = 0; q < 8; ++q)
#pragma unroll
            for (int x = 0; x < 4; ++x) acc[q][x] = bias[x];
#pragma unroll 8
        for (int k = 0; k < 64; ++k) { const f32x4 w = *(const f32x4*)(w4 + (size_t)k * 2048 + c4);
#pragma unroll
            for (int q = 0; q < 8; ++q) { const float hv = ha[(grp * 8 + q) * 64 + k];
#pragma unroll
                for (int x = 0; x < 4; ++x) acc[q][x] += hv * w[x]; } }
#pragma unroll
        for (int q = 0; q < 8; ++q) { const int j = j0 + grp * 8 + q; const float tj = (float)j / (float)(L - 1); float v[4];
#pragma unroll
            for (int x = 0; x < 4; ++x) v[x] = acc[q][x] * expf(-tj * ad[x]);
            if (!(isb && j == 0)) {
#pragma unroll
                for (int x = 0; x < 4; ++x) asum[x] += fabsf(v[x]);
                const int m = isb ? L - j : L + j;
                u32x2 w; w.x = pk2(v[0], v[1]); w.y = pk2(v[2], v[3]);
                *(u32x2*)(KT + (size_t)m * 1024 + ch) = w; } }
    }
    *(f32x4*)(kp + c4) = (f32x4){asum[0], asum[1], asum[2], asum[3]};
    if (tile == 0 && tid < 256) *(u32x2*)(KT + tid * 4) = (u32x2){0u, 0u};
    __syncthreads();
}


__device__ __forceinline__ void r_transpose_tile(const bf16* KTb, bf16* Rb, int L, int tile, LAS unsigned short* sm, int tid) {
    const int mb = tile >> 4, cb = tile & 15, m0 = mb * 64, c0 = cb * 64;
    { const int mr = tid >> 3, cq = tid & 7; const u32x4 v = *(const u32x4*)(KTb + (size_t)(m0 + mr) * 1024 + c0 + 8 * cq);
      LAS unsigned* d = (LAS unsigned*)(sm + mr * 66 + 8 * cq); d[0] = v.x; d[1] = v.y; d[2] = v.z; d[3] = v.w; }
    __syncthreads();
    { const int cc = tid >> 3, mq = tid & 7; bf16* rrow = Rb + (size_t)(c0 + cc) * 2 * L;
#pragma unroll
      for (int k = 0; k < 8; ++k) { const int mm = mq + 8 * k, m = m0 + mm; const unsigned short val = sm[mm * 66 + cc];
          if (m == 0) rrow[0] = 0; else rrow[2 * L - m] = val; } }
    __syncthreads();
}

template <int RHO> __device__ __forceinline__ bf16x8 shift_frag(const u32x4& c0, const u32x4& c1) {
    const unsigned w[8] = {c0.x, c0.y, c0.z, c0.w, c1.x, c1.y, c1.z, c1.w}; u32x4 o;
    if constexpr ((RHO & 1) == 0) { o.x = w[RHO / 2]; o.y = w[RHO / 2 + 1]; o.z = w[RHO / 2 + 2]; o.w = w[RHO / 2 + 3]; }
    else { constexpr int b = RHO / 2; o.x = __builtin_amdgcn_alignbit(w[b + 1], w[b], 16); o.y = __builtin_amdgcn_alignbit(w[b + 2], w[b + 1], 16);
           o.z = __builtin_amdgcn_alignbit(w[b + 3], w[b + 2], 16); o.w = __builtin_amdgcn_alignbit(w[b + 4], w[b + 3], 16); }
    return __builtin_bit_cast(bf16x8, o);
}

typedef unsigned u32x4a4 __attribute__((ext_vector_type(4), aligned(4)));
template <bool PROMPT, int HALF>
__device__ __forceinline__ void conv_item(unsigned char* ws, KArgs ka, int ib, int oct, int g, LAS unsigned char* lds, int tid, int lane, int wave) {
    constexpr int L = PROMPT ? TP : LS;
    { unsigned ones_ = ~0u; asm volatile("" : "+s"(ones_)); lane = (int)__builtin_amdgcn_mbcnt_hi(ones_, __builtin_amdgcn_mbcnt_lo(ones_, 0u)); }
    const int c = oct * 8 + wave, c0 = oct * 8;
    const bf16* Rc = (const bf16*)(ws + WS_R) + (PROMPT ? (size_t)0 : (size_t)2 * TP * 1024) + (size_t)c * 2 * L + L;
    const int nn = lane & 15, kq = lane >> 4;
    const int xa = 8 * kq - 2 * nn;
    LAS unsigned char* vl = lds + wave * (33 * 528);
    { const bf16* Vg = (const bf16*)(ws + WS_VVT) + (size_t)c * T + (PROMPT ? 0 : TP + 4 * g * LS);
      __syncthreads();
#pragma unroll 4
      for (int it = 0; it < 16; ++it) { const int s_ = (it * 64 + lane) * 8; *(LAS u32x4*)(vl + (s_ >> 8) * 528 + (s_ & 255) * 2) = *(const u32x4*)(Vg + s_); }
      unsigned zz_ = 0u; asm volatile("" : "+v"(zz_));
      if (lane < 33) *(LAS u32x4*)(vl + 32 * 528 + lane * 16) = (u32x4){zz_, zz_, zz_, zz_}; }
    constexpr int NB = PROMPT ? 32 : 8, GS = PROMPT ? 16 : 4;
    const int nbv = PROMPT ? nn : (nn >> 2);
    LAS unsigned char* vcol = vl + 16 * kq + (PROMPT ? 0 : 8 * (nn & 3)) * 528;
    const int zrow = PROMPT ? 32 : 32 - 8 * (nn & 3);
    constexpr int W = (HALF == 2) ? 8 : 4, MO = (HALF == 1) ? 4 : 0;
    f32x4 acc[2][W][2];
#pragma unroll
    for (int r = 0; r < 2; ++r)
#pragma unroll
        for (int q = 0; q < W; ++q)
#pragma unroll
            for (int gg = 0; gg < 2; ++gg) acc[r][q][gg] = (f32x4){0.f, 0.f, 0.f, 0.f};
    constexpr int E0 = PROMPT ? -255 : -63, E1 = PROMPT ? -135 : -39, E2 = PROMPT ? 129 : 33, E3 = PROMPT ? 257 : 65;
    static_assert((E1 - E0) % 8 == 0 && (E2 - E1) % 8 == 0 && (E3 - E2) % 8 == 0, "segments are whole 8-step blocks");
    constexpr int DA = (HALF == 2) ? 2 : 4;
    u32x4 rh[DA]; unsigned rl[DA];
    u32x4 F0[W], F1[W];
#define CONV_LOADA(e_, k_) do { const int xh_ = min(32 * (e_) + xa, L - 8); rh[k_] = *(const u32x4a4*)(Rc + xh_); asm volatile("" ::: "memory"); rl[k_] = *(const unsigned*)(Rc + xh_ - 2); } while (0)
#define CONV_LDF(m_, gsel_, dst_) do { const int rr_ = nbv + (gsel_) * GS + ((m_) >> 3); const int row_ = ((unsigned)rr_ < (unsigned)NB) ? rr_ : zrow; \
        dst_ = *(const LAS u32x4*)(vcol + row_ * 528 + 64 * ((m_) & 7)); } while (0)
#define CONV_MM(r0_, q_, gg_, a_, f_) acc[r0_][q_][gg_] = __builtin_amdgcn_mfma_f32_16x16x32_bf16(a_, __builtin_bit_cast(bf16x8, f_), acc[r0_][q_][gg_], 0, 0, 0)
#define CONV_STEP(j, DO0, DO1) do { const int ee_ = e + (j); \
        const u32x4 ah_ = rh[(j) % DA]; const unsigned al_ = rl[(j) % DA]; \
        CONV_LOADA(ee_ + DA, (j) % DA); \
        asm volatile("" ::: "memory"); \
        u32x4 as_; as_.x = __builtin_amdgcn_alignbit(ah_.x, al_, 16); as_.y = __builtin_amdgcn_alignbit(ah_.y, ah_.x, 16); as_.z = __builtin_amdgcn_alignbit(ah_.z, ah_.y, 16); as_.w = __builtin_amdgcn_alignbit(ah_.w, ah_.z, 16); \
        const bf16x8 a0_ = __builtin_bit_cast(bf16x8, ah_), a1_ = __builtin_bit_cast(bf16x8, as_); \
        __builtin_amdgcn_s_setprio(1); \
        if (DO0) { CONV_MM(0, 0, 0, a0_, F0[(j) % W]); CONV_MM(1, 0, 0, a1_, F0[(j) % W]); } \
        if (DO1) { CONV_MM(0, 0, 1, a0_, F1[(j) % W]); CONV_MM(1, 0, 1, a1_, F1[(j) % W]); } \
        if (DO0) CONV_LDF(ee_ + MO + W, 0, F0[(j) % W]); \
        if (DO1) CONV_LDF(ee_ + MO + W, 1, F1[(j) % W]); \
        _Pragma("unroll") for (int q_ = 1; q_ < W; ++q_) { \
            if (DO0) { CONV_MM(0, q_, 0, a0_, F0[((j) + q_) % W]); CONV_MM(1, q_, 0, a1_, F0[((j) + q_) % W]); } \
            if (DO1) { CONV_MM(0, q_, 1, a0_, F1[((j) + q_) % W]); CONV_MM(1, q_, 1, a1_, F1[((j) + q_) % W]); } } \
        __builtin_amdgcn_s_setprio(0); \
        __builtin_amdgcn_sched_barrier(0); } while (0)
#define CONV_BLOCK(DO0, DO1) do { CONV_STEP(0, DO0, DO1); CONV_STEP(1, DO0, DO1); CONV_STEP(2, DO0, DO1); CONV_STEP(3, DO0, DO1); CONV_STEP(4, DO0, DO1); CONV_STEP(5, DO0, DO1); CONV_STEP(6, DO0, DO1); CONV_STEP(7, DO0, DO1); } while (0)
#pragma unroll
    for (int k = 0; k < DA; ++k) CONV_LOADA(E0 + k, k);
    { unsigned zz_ = 0u; asm volatile("" : "+v"(zz_));
#pragma unroll
      for (int k = 0; k < W; ++k) F1[k] = (u32x4){zz_, zz_, zz_, zz_}; }
    for (int e = E0; e < E1; e += 8) CONV_BLOCK(false, true);
    { unsigned zz_ = 0u; asm volatile("" : "+v"(zz_));
#pragma unroll
      for (int k = 0; k < W; ++k) F0[k] = (u32x4){zz_, zz_, zz_, zz_}; }
    for (int e = E1; e < E2; e += 8) CONV_BLOCK(true, true);
    for (int e = E2; e < E3; e += 8) CONV_BLOCK(true, false);
#undef CONV_BLOCK
#undef CONV_STEP
#undef CONV_MM
#undef CONV_LDF
#undef CONV_LOADA
    __syncthreads();
    int lane2; { unsigned ones_ = ~0u; asm volatile("" : "+s"(ones_)); lane2 = (int)__builtin_amdgcn_mbcnt_hi(ones_, __builtin_amdgcn_mbcnt_lo(ones_, 0u)); }
    const int nn2 = lane2 & 15, kq2 = lane2 >> 4;
    float nsum = 0.f;
    { const float* kq_ = (const float*)(ws + WS_KPART) + ((size_t)ib * 320 + (PROMPT ? 0 : 256)) * 2048; constexpr int ntile = PROMPT ? 256 : 64;
      for (int q = lane2; q < ntile; q += 64) nsum += kq_[(size_t)q * 2048 + c] + kq_[(size_t)q * 2048 + 1024 + c];
      nsum = wave_sum(nsum); }
    const float inv = 1.0f / nsum;
    LAS float* stage = (LAS float*)lds;
    const int tid2 = wave * 64 + lane2;
    const float* dbias = ka->in[I_HD] + ib * 1024 + c0;
    const bf16* X0B = (const bf16*)(ws + WS_X0); const bf16* VVB = (const bf16*)(ws + WS_VV); bf16* AMIX = (bf16*)(ws + WS_AMIX);
#pragma unroll
    for (int h = 0; h < 2; ++h) {
        if (HALF != 2 && h != HALF) continue;
#pragma unroll
        for (int rp = 0; rp < 4; ++rp)
#pragma unroll
            for (int r0 = 0; r0 < 2; ++r0)
#pragma unroll
                for (int gg = 0; gg < 2; ++gg)
#pragma unroll
                    for (int j = 0; j < 4; ++j) { const int tl = 32 * rp + 2 * (4 * kq2 + j) + r0; stage[wave * 4096 + tl * 32 + 16 * gg + nn2] = acc[r0][(HALF == 2 ? 4 * h : 0) + rp][gg][j] * inv; }
        __syncthreads();
        float db[8];
#pragma unroll
        for (int q = 0; q < 8; ++q) db[q] = dbias[q];
#pragma unroll 2
        for (int k = 0; k < 8; ++k) { const int row = tid2 + 512 * k, n = row & 31, tl = row >> 5;
            int t; if (PROMPT) t = 256 * n + 128 * h + tl; else t = TP + (4 * g + (n & 3)) * LS + 256 * (n >> 2) + 128 * h + tl;
            float y[8];
#pragma unroll
            for (int q = 0; q < 8; ++q) y[q] = stage[q * 4096 + row];
            const u32x4 xv = *(const u32x4*)(X0B + (size_t)t * 1024 + c0), vv = *(const u32x4*)(VVB + (size_t)t * 1024 + c0);
            u32x4 o;
            o.x = pk2((y[0] + bflo(vv.x) * db[0]) * bflo(xv.x), (y[1] + bfhi(vv.x) * db[1]) * bfhi(xv.x));
            o.y = pk2((y[2] + bflo(vv.y) * db[2]) * bflo(xv.y), (y[3] + bfhi(vv.y) * db[3]) * bfhi(xv.y));
            o.z = pk2((y[4] + bflo(vv.z) * db[4]) * bflo(xv.z), (y[5] + bfhi(vv.z) * db[5]) * bfhi(xv.z));
            o.w = pk2((y[6] + bflo(vv.w) * db[6]) * bflo(xv.w), (y[7] + bfhi(vv.w) * db[7]) * bfhi(xv.w));
            *(u32x4*)(AMIX + (size_t)t * D + 1024 + c0) = o; }
        __syncthreads();
    }
}

__device__ __forceinline__ void seq_of(int t, int& s0, int& L) { if (t < TP) { s0 = 0; L = TP; } else { s0 = TP + ((t - TP) / LS) * LS; L = LS; } }

__global__ void __launch_bounds__(512, 2) fwd_kernel(Args args) {
    extern __shared__ __attribute__((aligned(16))) unsigned char lds_raw[];
    LAS unsigned char* lds = (LAS unsigned char*)lds_raw;
    const int tid0 = threadIdx.x; const int wave0 = __builtin_amdgcn_readfirstlane(tid0 >> 6);
    const int G = gridDim.x, NGW = G * 8;
#define PHASE_IDS unsigned ones_ = ~0u; asm volatile("" : "+s"(ones_)); const int lane = (int)__builtin_amdgcn_mbcnt_hi(ones_, __builtin_amdgcn_mbcnt_lo(ones_, 0u)); const int wave = wave0, tid = wave * 64 + lane, gw = blockIdx.x * 8 + wave; (void)tid; (void)lane; (void)gw; KArgs ka = (KArgs)__builtin_amdgcn_kernarg_segment_ptr(); asm volatile("" : "+s"(ka)); unsigned char* const ws = ka->ws; (void)ws; \
    bf16* const XB = (bf16*)(ws + WS_XB); bf16* const HB = (bf16*)(ws + WS_H); bf16* const AMIX = (bf16*)(ws + WS_AMIX); bf16* const PB = (bf16*)(ws + WS_P); bf16* const X0B = (bf16*)(ws + WS_X0); bf16* const VVB = (bf16*)(ws + WS_VV); \
    float* const PART = (float*)(ws + WS_PART); float* const OUT = ka->out; (void)XB; (void)HB; (void)AMIX; (void)PB; (void)X0B; (void)VVB; (void)PART; (void)OUT;
    unsigned char* ws0 = args.ws;
    volatile LAS unsigned* MISC = (volatile LAS unsigned*)(lds + MISC_OFF);
    if (tid0 < 64) MISC[tid0] = 0u;
    __syncthreads();
    XcdBarrier bar; bar.bar = (unsigned*)(ws0 + WS_CTL) + 4096; bar.x = 0; bar.st = MISC + 8;
#if !MK_PER_PHASE
    bar = xcd_barrier_post((unsigned*)(ws0 + WS_CTL) + 4096, MISC + 8);
#endif
    const int lo = args.ph_lo, hi = args.ph_hi;
#define RUN(k) (lo <= (k) && (k) < hi)
#if MK_PER_PHASE
#define SEAM(k) do { } while (0)
#else
#define SEAM(k) do { if (RUN(k) && RUN((k) + 1)) xcd_barrier(bar); } while (0)
#endif
    int ph = 0;

    if (RUN(ph)) { PHASE_IDS
        for (int step = 0; step < 2; ++step) {
            if ((step == 0) != ((blockIdx.x & 1) != 0)) {
                for (int jb = blockIdx.x; jb < 640; jb += G) filter_job(ka, jb, (LAS float*)lds, tid);
            } else {
        for (int m = gw; m < T; m += NGW) {
            const float* xr = (m < TP) ? ka->in[I_XP] + (size_t)m * D : ka->in[I_XS] + (size_t)(m - TP) * D;
            const f32x4* x4 = (const f32x4*)xr + lane; float ss = 0.f; u32x2* o = (u32x2*)(XB + (size_t)m * D) + lane;
#pragma unroll
            for (int j = 0; j < 8; ++j) { const f32x4 v = x4[64 * j]; ss += (v[0] * v[0] + v[1] * v[1]) + (v[2] * v[2] + v[3] * v[3]); o[64 * j] = (u32x2){pk2(v[0], v[1]), pk2(v[2], v[3])}; }
            ss = wave_sum(ss);
            if (lane < 32) PART[(size_t)m * 32 + lane] = lane == 0 ? ss : 0.f;
        }
        cvt_slot(ka, 0, gw, NGW, lane);
            }
        }
    }
    SEAM(ph); ++ph;

    for (int l = 0; l < 4; ++l) {
        const int ib = l >> 1;
        for (int f = 0; f < 3; ++f) {
            if (f != 1) {
                if (RUN(ph)) { PHASE_IDS
                    unsigned char* fw = ws + WS_W + (size_t)(l * 2 + (f >> 1)) * SZ_FFN; pg8::Gemm g{XB, (const bf16*)fw, T, 2 * DFF, D, D, 64, 0, 0, 256 * 64 * 2}; pg8::StaticOrder S; S.init(T, 2 * DFF, G, (int)blockIdx.x);
                    pg8::EpiSwiGLU E{HB, PART};
                    pg8::gemm_phase<pg8::EpiSwiGLU, true>(lds, g, S, E, tid);
                }
                SEAM(ph); ++ph;
                if (RUN(ph)) { PHASE_IDS
                    unsigned char* fw = ws + WS_W + (size_t)(l * 2 + (f >> 1)) * SZ_FFN; pg8::Gemm g{HB, (const bf16*)(fw + SZ_WI), T, D, DFF, 64, 64, 0, 256 * 64 * 2, 256 * 64 * 2}; pg8::StaticOrder S; S.init(T, D, G, (int)blockIdx.x, 1);
                    pg8::EpiResid E{XB, PART, 0.5f};
                    pg8::gemm_phase<pg8::EpiResid, true>(lds, g, S, E, tid);
                }
                SEAM(ph); ++ph;
            } else {
                const bool even = (l & 1) == 0;
                if (RUN(ph)) { PHASE_IDS
                    const int N = even ? ABIN : QKV; unsigned char* mixw = ws + WS_WMIX + (size_t)ib * SZ_MIX;
                    pg8::Gemm g{XB, (const bf16*)(even ? mixw : mixw + SZ_ABIN + SZ_DD + SZ_POOL), T, N, D, D, 64, 0, 0, 256 * 64 * 2}; pg8::StaticOrder S; S.init(T, N, G, (int)blockIdx.x);
                    pg8::EpiScale E{HB, N, PART};
                    pg8::gemm_phase<pg8::EpiScale, true>(lds, g, S, E, tid);
                }
                SEAM(ph); ++ph;
                if (even) {
                    if (RUN(ph)) { PHASE_IDS
                        { const bf16* KT0 = (const bf16*)(ws + WS_KT + (size_t)ib * SZ_KT1); bf16* R0 = (bf16*)(ws + WS_R);
                          for (int tile = blockIdx.x; tile < 5120; tile += G) {
                              if (tile < 4096) r_transpose_tile(KT0, R0, TP, tile, (LAS unsigned short*)lds, tid);
                              else r_transpose_tile(KT0 + (size_t)2 * TP * 1024, R0 + (size_t)2 * TP * 1024, LS, tile - 4096, (LAS unsigned short*)lds, tid); } }
                        const float* cw = ka->in[I_HCW] + (size_t)ib * 3 * 3072; const float* cb = ka->in[I_HCB] + (size_t)ib * 3072;
                        bf16* VVT = (bf16*)(ws + WS_VVT);
                        LAS unsigned* vvl = (LAS unsigned*)lds;
                        for (int tile = blockIdx.x; tile < T / 32; tile += G) {
                          const int tok0 = tile * 32; int s0, L; seq_of(tok0, s0, L);
                          {
                            const int gq = wave & 3, th = wave >> 2, ck = gq * 32 + (lane & 31), c = ck * 8, tlocA = 16 * th + 8 * (lane >> 5), tA = tok0 + tlocA, tlA = tA - s0;
                            const u32x4 z = (u32x4){0u, 0u, 0u, 0u};
                            { const int hw = 1 << gq; float S[8] = {0, 0, 0, 0, 0, 0, 0, 0};
                              const bf16* ua = HB + (size_t)s0 * ABIN + c;
#define PREP_ROW(r) (((r) >= 0 && (r) < L) ? *(const u32x4*)(ua + (size_t)(r) * ABIN) : z)
#define PREP_ACC(S, v, sg) do { S[0] += sg bflo(v.x); S[1] += sg bfhi(v.x); S[2] += sg bflo(v.y); S[3] += sg bfhi(v.y); S[4] += sg bflo(v.z); S[5] += sg bfhi(v.z); S[6] += sg bflo(v.w); S[7] += sg bfhi(v.w); } while (0)
                              u32x4 vc[8], vin[7], vout[7];
#pragma unroll
                              for (int j = 0; j < 8; ++j) vc[j] = *(const u32x4*)(ua + (size_t)(tlA + j) * ABIN);
#pragma unroll
                              for (int j = 0; j < 7; ++j) { vin[j] = PREP_ROW(tlA + j + hw); vout[j] = PREP_ROW(tlA + j - hw); }
                              for (int q = 0; q < 2 * hw; ++q) { const u32x4 v = PREP_ROW(tlA - hw + q); PREP_ACC(S, v, +); }
#pragma unroll
                              for (int j = 0; j < 8; ++j) { const int tl = tlA + j; const int lo_ = max(tl - hw, 0), hi_ = min(tl + hw, L); const float inv = 1.0f / (float)(hi_ - lo_);
                                  const u32x4 v = vc[j];
                                  u32x4 o; o.x = pk2(S[0] * inv - bflo(v.x), S[1] * inv - bfhi(v.x)); o.y = pk2(S[2] * inv - bflo(v.y), S[3] * inv - bfhi(v.y));
                                  o.z = pk2(S[4] * inv - bflo(v.z), S[5] * inv - bfhi(v.z)); o.w = pk2(S[6] * inv - bflo(v.w), S[7] * inv - bfhi(v.w));
                                  *(u32x4*)(PB + (size_t)(s0 + tl) * 1024 + c) = o;
                                  if (j < 7) { const u32x4 va = vin[j], vs_ = vout[j]; PREP_ACC(S, va, +); PREP_ACC(S, vs_, -); } }
#undef PREP_ACC
#undef PREP_ROW
                            }
                            float x1k[8][8];
#pragma unroll
                            for (int comp = 0; comp < 3; ++comp) { const int cc = comp * 1024 + c; const bf16* ub = HB + (size_t)s0 * ABIN + 1024 + cc;
                                float w0[8], w1[8], w2[8], bb[8];
#pragma unroll
                                for (int e = 0; e < 8; e += 4) { const f32x4 a0 = *(const f32x4*)(cw + cc + e), a1 = *(const f32x4*)(cw + 3072 + cc + e), a2 = *(const f32x4*)(cw + 6144 + cc + e), a3 = *(const f32x4*)(cb + cc + e);
#pragma unroll
                                    for (int x = 0; x < 4; ++x) { w0[e + x] = a0[x]; w1[e + x] = a1[x]; w2[e + x] = a2[x]; bb[e + x] = a3[x]; } }
                                u32x4 rows[10];
#pragma unroll
                                for (int q = 0; q < 10; ++q) { const int r = tlA - 1 + q; rows[q] = (r >= 0 && r < L) ? *(const u32x4*)(ub + (size_t)r * ABIN) : z; }
#pragma unroll
                                for (int j = 0; j < 8; ++j) { float uc[8];
                                    const unsigned am[4] = {rows[j].x, rows[j].y, rows[j].z, rows[j].w}, a0[4] = {rows[j + 1].x, rows[j + 1].y, rows[j + 1].z, rows[j + 1].w}, ap[4] = {rows[j + 2].x, rows[j + 2].y, rows[j + 2].z, rows[j + 2].w};
#pragma unroll
                                    for (int e = 0; e < 8; ++e) { const float xm = (e & 1) ? bfhi(am[e >> 1]) : bflo(am[e >> 1]), x0 = (e & 1) ? bfhi(a0[e >> 1]) : bflo(a0[e >> 1]), xp = (e & 1) ? bfhi(ap[e >> 1]) : bflo(ap[e >> 1]);
                                        uc[e] = xm * w0[e] + x0 * w1[e] + xp * w2[e] + bb[e]; }
                                    const size_t orow = (size_t)(tA + j) * 1024 + c;
                                    if (comp == 0) { u32x4 o; o.x = pk2(uc[0], uc[1]); o.y = pk2(uc[2], uc[3]); o.z = pk2(uc[4], uc[5]); o.w = pk2(uc[6], uc[7]); *(u32x4*)(X0B + orow) = o; }
                                    else if (comp == 1) {
#pragma unroll
                                        for (int e = 0; e < 8; ++e) x1k[j][e] = uc[e]; }
                                    else { u32x4 o; o.x = pk2(uc[0] * x1k[j][0], uc[1] * x1k[j][1]); o.y = pk2(uc[2] * x1k[j][2], uc[3] * x1k[j][3]); o.z = pk2(uc[4] * x1k[j][4], uc[5] * x1k[j][5]); o.w = pk2(uc[6] * x1k[j][6], uc[7] * x1k[j][7]);
                                        *(u32x4*)(VVB + orow) = o; LAS unsigned* dl = vvl + (tlocA + j) * 513 + ck * 4; dl[0] = o.x; dl[1] = o.y; dl[2] = o.z; dl[3] = o.w; } } }
                          }
                          __syncthreads();
                          { int l2_ = lane; asm volatile("" : "+v"(l2_)); const LAS unsigned short* vs = (const LAS unsigned short*)vvl; const int tt = l2_ & 31, cp = l2_ >> 5;
                            for (int k = 0; k < 64; ++k) { const int c = 2 * (wave * 64 + k) + cp; VVT[(size_t)c * T + tok0 + tt] = vs[tt * 1026 + c]; } }
                          __syncthreads();
                        }
                    }
                    SEAM(ph); ++ph;
                    if (RUN(ph)) {
                        { PHASE_IDS
                        { unsigned char* mixw = ws + WS_WMIX + (size_t)ib * SZ_MIX; pg8::Gemm g{PB, (const bf16*)(mixw + SZ_ABIN + SZ_DD), T, 1024, 256, 1024, 256, 512}; pg8::StaticOrder S; S.init(T, 1024, G, (int)blockIdx.x);
                          pg8::EpiColScale E{AMIX, D, ka->in[I_POOLS] + ib * 1024};
                          pg8::gemm_phase<pg8::EpiColScale, true>(lds, g, S, E, tid); }
                        }
                        { PHASE_IDS
                        for (int it = (int)blockIdx.x; it < 512; it += G) {
                            if (it < 256) { if (it & 1) conv_item<true, 1>(ws, ka, ib, it >> 1, 0, lds, tid, lane, wave); else conv_item<true, 0>(ws, ka, ib, it >> 1, 0, lds, tid, lane, wave); }
                            else conv_item<false, 2>(ws, ka, ib, (it - 256) >> 1, (it - 256) & 1, lds, tid, lane, wave); }
                        }
                    }
                    SEAM(ph); ++ph;
                } else {
                    if (RUN(ph)) { PHASE_IDS
                        int tab_key = -1;
                        for (int u = blockIdx.x; u < 1536; u += G) att::attn_unit(HB, AMIX, ka->in[I_SINK] + ib * 16, ka->in[I_RELB], u, lds, tid, lane, wave, tab_key);
                    }
                    SEAM(ph); ++ph;
                }
                if (RUN(ph)) { PHASE_IDS
                    unsigned char* mixw = ws + WS_WMIX + (size_t)ib * SZ_MIX; pg8::Gemm g{AMIX, (const bf16*)(even ? mixw + SZ_ABIN : mixw + SZ_ABIN + SZ_DD + SZ_POOL + SZ_QKV), T, D, D, D, 64, 0, 0, 256 * 64 * 2}; pg8::StaticOrder S; S.init(T, D, G, (int)blockIdx.x, 1);
                    pg8::EpiResid E{XB, PART, 1.0f};
                    pg8::gemm_phase<pg8::EpiResid, true>(lds, g, S, E, tid);
                }
                SEAM(ph); ++ph;
            }
        }
    }
    if (RUN(ph)) { PHASE_IDS
        const float* gn = ka->in[I_NFIN];
        for (int m = gw; m < T; m += NGW) {
            float s = lane < 32 ? PART[(size_t)m * 32 + lane] : 0.f; s = wave_sum(s); const float rs = 1.0f / sqrtf(s * (1.0f / D) + EPS);
            f32x4* x4 = (f32x4*)(OUT + (size_t)m * D) + lane; const f32x4* g4 = (const f32x4*)gn + lane; const u32x2* xb2 = (const u32x2*)(XB + (size_t)m * D) + lane;
#pragma unroll
            for (int j = 0; j < 8; ++j) { const u32x2 xw = xb2[64 * j]; const f32x4 v = (f32x4){bflo(xw.x), bfhi(xw.x), bflo(xw.y), bfhi(xw.y)}, gg = g4[64 * j]; x4[64 * j] = v * rs * gg; }
        }
    }
#undef RUN
#undef SEAM
}

extern "C" void kernel_launch(void* const* d_in, const int* in_sizes, int n_in, void* d_out, int out_size, void* d_ws, size_t ws_size, hipStream_t stream) {
    static int grid = 0;
    if (grid == 0) {
        if (n_in != 30 || out_size != T * D || ws_size < WS_END) { fprintf(stderr, "kernel_launch: unexpected shapes (n_in %d, out %d, ws %zu < %zu)\n", n_in, out_size, ws_size, (size_t)WS_END); grid = -1; return; }
        int dev = 0, cus = 0, per_cu = 0;
        if (hipGetDevice(&dev) != hipSuccess || hipDeviceGetAttribute(&cus, hipDeviceAttributeMultiprocessorCount, dev) != hipSuccess) { grid = -1; return; }
        if (hipFuncSetAttribute((const void*)fwd_kernel, hipFuncAttributeMaxDynamicSharedMemorySize, LDS_BYTES) != hipSuccess) { fprintf(stderr, "kernel_launch: hipFuncSetAttribute failed\n"); grid = -1; return; }
        if (hipOccupancyMaxActiveBlocksPerMultiprocessor(&per_cu, (const void*)fwd_kernel, 512, LDS_BYTES) != hipSuccess || per_cu < 1) { fprintf(stderr, "kernel_launch: occupancy query reports %d\n", per_cu); }
        (void)hipGetLastError();
        grid = cus;
    }
    if (grid < 0) return;
    (void)hipMemsetAsync((char*)d_ws + WS_CTL, 0, CTL_BYTES, stream);
    Args a{};
    for (int i = 0; i < 30; ++i) a.in[i] = (const float*)d_in[i];
    a.out = (float*)d_out; a.ws = (unsigned char*)d_ws;
#if MK_PER_PHASE
    for (int p = 0; p < NPHASES; ++p) { a.ph_lo = p; a.ph_hi = p + 1; hipLaunchKernelGGL(fwd_kernel, dim3(grid), dim3(512), LDS_BYTES, stream, a); }
#else
    a.ph_lo = 0; a.ph_hi = NPHASES;
    hipLaunchKernelGGL(fwd_kernel, dim3(grid), dim3(512), LDS_BYTES, stream, a);
#endif
}
```

```cpp
#include <hip/hip_runtime.h>
#include <cstdio>
#include <cstdint>

#ifndef MK_PER_PHASE
#define MK_PER_PHASE 0
#endif

#define LAS __attribute__((address_space(3)))
#define GAS __attribute__((address_space(1)))
typedef unsigned short bf16;
typedef short bf16x8 __attribute__((ext_vector_type(8)));
typedef float f32x4 __attribute__((ext_vector_type(4)));
typedef float f32x2 __attribute__((ext_vector_type(2)));
typedef unsigned u32x4 __attribute__((ext_vector_type(4)));
typedef unsigned u32x2 __attribute__((ext_vector_type(2)));
typedef float f32x16 __attribute__((ext_vector_type(16)));

constexpr int D = 2048, DFF = 5632, T = 24576, TP = 8192, LS = 2048, NSEQ_S = 8;
constexpr int NH = 16, NKV = 4, HD = 128, QKV = 3072, ABIN = 4096, PW = 1024, HW = 1024;
constexpr float EPS = 1e-6f;
constexpr int NPHASES = 32;

constexpr size_t SZ_WI = (size_t)2 * DFF * D * 2, SZ_WO = (size_t)D * DFF * 2;
constexpr size_t SZ_FFN = SZ_WI + SZ_WO;
constexpr size_t SZ_ABIN = (size_t)ABIN * D * 2, SZ_DD = (size_t)D * D * 2, SZ_POOL = (size_t)1024 * 256 * 2, SZ_QKV = (size_t)QKV * D * 2;
constexpr size_t SZ_MIX = SZ_ABIN + SZ_DD + SZ_POOL + SZ_QKV + SZ_DD;
constexpr size_t WS_CTL = 0, CTL_BYTES = 1u << 20;
constexpr size_t WS_W = CTL_BYTES;
constexpr size_t WS_WMIX = WS_W + 8 * SZ_FFN;
constexpr size_t WS_XB = WS_WMIX + 2 * SZ_MIX;
constexpr size_t WS_H = WS_XB + (size_t)T * D * 2;
constexpr size_t WS_AMIX = WS_H + (size_t)T * DFF * 2;
constexpr size_t WS_P = WS_AMIX + (size_t)T * D * 2;
constexpr size_t WS_X0 = WS_P + (size_t)T * 1024 * 2;
constexpr size_t WS_VV = WS_X0 + (size_t)T * 1024 * 2;
constexpr size_t SZ_KT1 = (size_t)(2 * TP + 2 * LS) * 1024 * 2;
constexpr size_t WS_KT = WS_VV + (size_t)T * 1024 * 2;
constexpr size_t WS_PART = WS_KT + 2 * SZ_KT1;
constexpr size_t WS_KPART = WS_PART + (size_t)T * 32 * 4;
constexpr size_t WS_R = WS_KPART + (size_t)2 * 320 * 2048 * 4;
constexpr size_t WS_END = WS_R + (size_t)(2 * TP + 2 * LS) * 1024 * 2;
constexpr size_t WS_VVT = WS_H + (size_t)T * ABIN * 2;
static_assert(WS_VVT + (size_t)T * 1024 * 2 <= WS_AMIX, "VVT must fit behind U in the H region");
static_assert(WS_END <= 1476395008ull, "workspace map exceeds 4x largest input");

constexpr int RING_BYTES = 131072, LDS_BYTES = 147456, MISC_OFF = LDS_BYTES - 256;

#define LDS_WAIT() asm volatile("s_waitcnt lgkmcnt(0)" ::: "memory")
#define VM_WAIT() asm volatile("s_waitcnt vmcnt(0)" ::: "memory")
__device__ __forceinline__ unsigned f2bf(float f) { unsigned u = __builtin_bit_cast(unsigned, f); return (u + 0x7fffu + ((u >> 16) & 1u)) >> 16; }
__device__ __forceinline__ unsigned pk2(float lo, float hi) { return f2bf(lo) | (f2bf(hi) << 16); }
__device__ __forceinline__ unsigned cvt_pk_bf16(float lo, float hi) { unsigned r; asm volatile("v_cvt_pk_bf16_f32 %0, %1, %2" : "=v"(r) : "v"(lo), "v"(hi)); return r; }
__device__ __forceinline__ float bflo(unsigned w) { return __builtin_bit_cast(float, w << 16); }
__device__ __forceinline__ float bfhi(unsigned w) { return __builtin_bit_cast(float, w & 0xffff0000u); }
__device__ __forceinline__ float bf1(bf16 b) { return __builtin_bit_cast(float, (unsigned)b << 16); }
__device__ __forceinline__ float wave_sum(float v) {
#pragma unroll
    for (int o = 1; o < 64; o <<= 1) v += __shfl_xor(v, o);
    return v;
}
__device__ __forceinline__ float wave_max(float v) {
#pragma unroll
    for (int o = 1; o < 64; o <<= 1) v = fmaxf(v, __shfl_xor(v, o));
    return v;
}

#define XB_TMO      128
#define XB_XCNT(j)  (256  + 64 * (j))
#define XB_XSUB(j)  (1280 + 64 * (j))
#define XB_XGEN(j)  (2304 + 64 * (j))
#define XB_TOP      3328
#define XB_TOPGEN   3392
#define XCD_BAR_WORDS 3456
#define XB_SPIN_CAP (1u << 18)
__device__ __forceinline__ unsigned xb_ld(unsigned* p)              { return __hip_atomic_load(p, __ATOMIC_RELAXED, __HIP_MEMORY_SCOPE_AGENT); }
__device__ __forceinline__ unsigned xb_add(unsigned* p, unsigned v) { return __hip_atomic_fetch_add(p, v, __ATOMIC_RELAXED, __HIP_MEMORY_SCOPE_AGENT); }
__device__ __forceinline__ unsigned xb_xcc_id() { return (unsigned)__builtin_amdgcn_s_getreg((3 << 11) | 20) & 0xFu; }
#define XB_SPIN(cond, bar) do { unsigned _sp = 0; while (cond) { __builtin_amdgcn_s_sleep(1); \
    if ((++_sp & 255u) == 0u) { if (xb_ld(&(bar)[XB_TMO])) break; if (_sp > XB_SPIN_CAP) { atomicAdd(&(bar)[XB_TMO], 1u); break; } } } } while (0)
struct XcdBarrier { unsigned* bar; unsigned x; volatile LAS unsigned* st; };
__device__ __forceinline__ XcdBarrier xcd_barrier_post(unsigned* bar, volatile LAS unsigned* st) {
    XcdBarrier b; b.bar = bar; b.x = xb_xcc_id(); b.st = st;
    if (threadIdx.x == 0) (void)xb_add(&bar[XB_XCNT(b.x)], 1u);
    return b;
}
__device__ __forceinline__ void xcd_barrier_complete(unsigned* bar, unsigned x, unsigned& nloc, unsigned& nx) {
    const unsigned G = gridDim.x * gridDim.y * gridDim.z;
    unsigned sum, cnt, mine, sp = 0u;
    for (;;) {
        sum = 0u; cnt = 0u; mine = 0u;
#pragma unroll
        for (unsigned j = 0; j < 16; ++j) { const unsigned c = xb_ld(&bar[XB_XCNT(j)]); sum += c; cnt += (c > 0u) ? 1u : 0u; mine = (j == x) ? c : mine; }
        if (sum == G) break;
        __builtin_amdgcn_s_sleep(1);
        if ((++sp & 255u) == 0u) { if (xb_ld(&bar[XB_TMO])) break; if (sp > XB_SPIN_CAP) { atomicAdd(&bar[XB_TMO], 1u); break; } }
    }
    nloc = mine > 0u ? mine : 1u; nx = cnt > 0u ? cnt : 1u;
}
__device__ __forceinline__ void xcd_barrier(const XcdBarrier& b) {
    asm volatile("s_waitcnt vmcnt(0)" ::: "memory");
    __syncthreads();
    if (threadIdx.x == 0) {
        unsigned* bar = b.bar;
        __builtin_amdgcn_s_waitcnt(0);
        unsigned nloc = b.st[0], nx = b.st[1];
        if (nloc == 0u) { xcd_barrier_complete(bar, b.x, nloc, nx); b.st[0] = nloc; b.st[1] = nx; }
        const unsigned old = xb_add(&bar[XB_XSUB(b.x)], 1u);
        const unsigned gen = old / nloc;
        if (old + 1u == (gen + 1u) * nloc) {
            __builtin_amdgcn_fence(__ATOMIC_RELEASE, "agent");
            asm volatile("s_waitcnt vmcnt(0)" ::: "memory");
            const unsigned og = xb_add(&bar[XB_TOP], 1u);
            const unsigned tg = og / nx;
            if (og + 1u == (tg + 1u) * nx) xb_add(&bar[XB_TOPGEN], 1u);
            else XB_SPIN(xb_ld(&bar[XB_TOPGEN]) == tg, bar);
            __builtin_amdgcn_fence(__ATOMIC_ACQUIRE, "agent");
            xb_add(&bar[XB_XGEN(b.x)], 1u);
            asm volatile("s_waitcnt vmcnt(0)" ::: "memory");
        } else {
            XB_SPIN(xb_ld(&bar[XB_XGEN(b.x)]) == gen, bar);
            __builtin_amdgcn_fence(__ATOMIC_ACQUIRE, "agent");
            asm volatile("s_waitcnt vmcnt(0)" ::: "memory");
        }
    }
    __syncthreads();
}

namespace pg8 {
constexpr int BM = 256, BK = 64, HALF = 128, HTB = HALF * BK * 2, STAGE_BYTES = 8 * HTB, NXCD = 8, WGM = 8;
__host__ __device__ __forceinline__ int lds_byte(int r, int c) { const int st = (r >> 4) * 2 + (c >> 5), rr = r & 15, cc = c & 31, ob = rr * 64 + cc * 2; return st * 1024 + (ob ^ (((ob >> 9) & 1) << 5)); }
__host__ __device__ __forceinline__ void stage_rc(int b, int& R, int& C) { const int st = b / 1024, sb = b % 1024, swz = sb ^ (((sb >> 9) & 1) << 5); R = (st >> 1) * 16 + swz / 64; C = (st & 1) * 32 + (swz % 64) / 2; }
__host__ __device__ __forceinline__ int perm32(int rho) { const int n = rho >> 4, i = rho & 15; return 8 * (i >> 2) + 4 * n + (i & 3); }
struct Unit { int pm, pn; };
struct Gemm { const bf16* A; const bf16* Bt; int M, N, K, lda, ldb, acs; int ktA = 0, ktB = 0; };
struct StaticOrder {
    int nM, nN, nwg, G, c, wgm, rev;
    __device__ void init(int M, int N, int G_, int c_, int rev_ = 0) { nM = M / BM; nN = N / BM; nwg = nM * nN; G = G_; c = c_; wgm = (nN == 8) ? 4 : WGM; rev = rev_; }
    __device__ bool next(int i, Unit& u) const {
        const long L = (long)i * G + c; if (L >= nwg) return false;
        int wgid = (int)L; { const int q = nwg / NXCD, r = nwg % NXCD, xcd = wgid % NXCD, off = wgid / NXCD; wgid = (xcd < r ? xcd * (q + 1) : r * (q + 1) + (xcd - r) * q) + off; }
        const int nig = wgm * nN, gid = wgid / nig, fm = gid * wgm, gsz = (nM - fm) < wgm ? (nM - fm) : wgm;
        u.pm = fm + ((wgid % nig) % gsz); u.pn = (wgid % nig) / gsz; if (rev) u.pm = nM - 1 - u.pm; return true;
    }
};
template <class Epi, bool ALIGN_EPI>
__device__ __forceinline__ void gemm_phase(LAS unsigned char* lds, const Gemm g, const StaticOrder& S, const Epi& E, const int tid) {
    const int wid = __builtin_amdgcn_readfirstlane(tid >> 6), lane = tid & 63, wr = wid >> 2, wc = wid & 3, fr = lane & 15, fq = lane >> 4;
    const int K = g.K, nt = K / BK;
    unsigned voffA[2], voffB[2];
#pragma unroll
    for (int i = 0; i < 2; ++i) { int R, C; stage_rc(tid * 16 + i * 8192, R, C); const int Rb = (R & ~31) + perm32(R & 31);
        voffA[i] = (unsigned)(R * g.lda + C) * 2u; voffB[i] = (unsigned)(Rb * g.ldb + C) * 2u; }
    const size_t kstep = (size_t)(BK * 2), kstepA = g.ktA ? (size_t)g.ktA : kstep, kstepB = g.ktB ? (size_t)g.ktB : kstep;
    const size_t hstepA = (size_t)HALF * g.lda * 2, hstepB = (size_t)HALF * g.ldb * 2;
    const size_t tstepA = g.ktA ? (size_t)g.ktA * (size_t)nt : 2 * hstepA, tstepB = g.ktB ? (size_t)g.ktB * (size_t)nt : 2 * hstepB;
    const unsigned ldsw = (unsigned)wid * 1024u;
    const int aoff = lds_byte(wr * 64 + fr, fq * 8), boff = lds_byte(wc * 32 + fr, fq * 8);
#define PG8_SA(b, h) (((b) * 2 + (h)) * HTB)
#define PG8_SB(b, h) ((4 + (b) * 2 + (h)) * HTB)
#define PG8_STAGE(bufoff, gbase, voff) do { _Pragma("unroll") for (int _i = 0; _i < 2; ++_i) \
        __builtin_amdgcn_global_load_lds((const unsigned*)((const char*)(gbase) + (voff)[_i]), (LAS unsigned*)(lds + (bufoff) + ldsw + _i * 8192), 16, 0, 0); } while (0)
#define PG8_LDA(dst, b, h) do { _Pragma("unroll") for (int m = 0; m < 4; ++m) _Pragma("unroll") for (int k = 0; k < 2; ++k) dst[m][k] = *(const LAS bf16x8*)(lds + PG8_SA(b, h) + aoff + m * 2048 + k * 1024); } while (0)
#define PG8_LDB(dst, b, h) do { _Pragma("unroll") for (int n = 0; n < 2; ++n) _Pragma("unroll") for (int k = 0; k < 2; ++k) dst[n][k] = *(const LAS bf16x8*)(lds + PG8_SB(b, h) + boff + n * 2048 + k * 1024); } while (0)
#define PG8_MMA(ai, bj, At, Bt) do { __builtin_amdgcn_s_setprio(1); _Pragma("unroll") for (int m = 0; m < 4; ++m) _Pragma("unroll") for (int n = 0; n < 2; ++n) _Pragma("unroll") for (int k = 0; k < 2; ++k) \
        acc[ai][bj][m][n] = __builtin_amdgcn_mfma_f32_16x16x32_bf16(Bt[n][k], At[m][k], acc[ai][bj][m][n], 0, 0, 0); __builtin_amdgcn_s_setprio(0); } while (0)
#define PG8_WAIT_V(n) asm volatile("s_waitcnt vmcnt(" #n ")" ::: "memory")
#define PG8_WAIT_L(n) asm volatile("s_waitcnt lgkmcnt(" #n ")" ::: "memory")
#define PG8_BAR __builtin_amdgcn_s_barrier()
#define PG8_SCHED __builtin_amdgcn_sched_barrier(0)
    Unit cur, nxt; int ui = 0; int rs_pm = -1;
    if (!S.next(0, cur)) return;
    f32x4 acc[2][2][4][2];
#pragma unroll
    for (int a = 0; a < 2; ++a)
#pragma unroll
        for (int b = 0; b < 2; ++b)
#pragma unroll
            for (int m = 0; m < 4; ++m)
#pragma unroll
                for (int n = 0; n < 2; ++n) acc[a][b][m][n] = (f32x4){0.f, 0.f, 0.f, 0.f};
    bf16x8 At[4][2], B0[2][2], B1[2][2];
    const char* cA = (const char*)g.A + (size_t)cur.pm * tstepA + (size_t)cur.pn * g.acs; const char* cB = (const char*)g.Bt + (size_t)cur.pn * tstepB;
    PG8_STAGE(PG8_SB(0, 0), cB, voffB); PG8_STAGE(PG8_SB(0, 1), cB + hstepB, voffB); PG8_STAGE(PG8_SA(0, 0), cA, voffA); PG8_STAGE(PG8_SA(0, 1), cA + hstepA, voffA);
    if (wr == 1) PG8_BAR;
    PG8_WAIT_V(2); PG8_BAR;
    PG8_STAGE(PG8_SB(1, 0), cB + kstepB, voffB); PG8_STAGE(PG8_SA(1, 0), cA + kstepA, voffA); PG8_STAGE(PG8_SB(1, 1), cB + hstepB + kstepB, voffB);
    PG8_WAIT_V(6); PG8_BAR;
    for (;;) {
        const bool has_next = S.next(ui + 1, nxt);
        const char* nA = has_next ? (const char*)g.A + (size_t)nxt.pm * tstepA + (size_t)nxt.pn * g.acs : cA; const char* nB = has_next ? (const char*)g.Bt + (size_t)nxt.pn * tstepB : cB;
        for (int t = 0; t < nt; t += 2) {
            const bool last = (t == nt - 2);
            const char* a1 = cA + (size_t)(t + 1) * kstepA;
            const char* a2 = last ? nA : cA + (size_t)(t + 2) * kstepA; const char* b2 = last ? nB : cB + (size_t)(t + 2) * kstepB;
            const char* a3 = a2 + kstepA; const char* b3 = b2 + kstepB;
            PG8_LDB(B0, 0, 0); PG8_LDB(B1, 0, 1); PG8_SCHED; PG8_LDA(At, 0, 0); PG8_STAGE(PG8_SA(1, 1), a1 + hstepA, voffA);
            PG8_WAIT_V(8); PG8_WAIT_L(0); PG8_BAR; PG8_MMA(0, 0, At, B0); PG8_MMA(0, 1, At, B1); PG8_BAR; PG8_SCHED;
            PG8_LDA(At, 0, 1); PG8_STAGE(PG8_SB(0, 0), b2, voffB); PG8_STAGE(PG8_SB(0, 1), b2 + hstepB, voffB); PG8_STAGE(PG8_SA(0, 0), a2, voffA);
            PG8_WAIT_V(8); PG8_WAIT_L(0); PG8_BAR; PG8_MMA(1, 0, At, B0); PG8_MMA(1, 1, At, B1); PG8_BAR; PG8_SCHED;
            PG8_LDB(B0, 1, 0); PG8_LDB(B1, 1, 1); PG8_SCHED; PG8_LDA(At, 1, 0); PG8_STAGE(PG8_SA(0, 1), a2 + hstepA, voffA);
            PG8_WAIT_V(8); PG8_WAIT_L(0); PG8_BAR; PG8_MMA(0, 0, At, B0); PG8_MMA(0, 1, At, B1); PG8_BAR; PG8_SCHED;
            PG8_LDA(At, 1, 1); PG8_STAGE(PG8_SB(1, 0), b3, voffB); PG8_STAGE(PG8_SB(1, 1), b3 + hstepB, voffB); PG8_STAGE(PG8_SA(1, 0), a3, voffA);
            PG8_WAIT_V(8); PG8_WAIT_L(0); PG8_BAR; PG8_MMA(1, 0, At, B0); PG8_MMA(1, 1, At, B1); PG8_BAR; PG8_SCHED;
        }
        if constexpr (ALIGN_EPI) { if (wr == 0) PG8_BAR; }
        E(acc, cur, wr, wc, lds, rs_pm);
        if (!has_next) break;
        cur = nxt; cA = nA; cB = nB; ++ui;
        if constexpr (ALIGN_EPI) { if (wr == 1) PG8_BAR; }
    }
    PG8_WAIT_V(0);
    if constexpr (!ALIGN_EPI) { if (wr == 0) PG8_BAR; }
    PG8_BAR;
#undef PG8_SA
#undef PG8_SB
#undef PG8_STAGE
#undef PG8_LDA
#undef PG8_LDB
#undef PG8_MMA
#undef PG8_WAIT_V
#undef PG8_WAIT_L
#undef PG8_BAR
#undef PG8_SCHED
}

__device__ __forceinline__ u32x4 zero_frag() { unsigned z_ = 0u; asm volatile("" : "+v"(z_)); return (u32x4){z_, z_, z_, z_}; }
__device__ __forceinline__ void zero_acc(f32x4& a, u32x4& zb) { asm volatile("" : "+v"(zb));
    a = __builtin_amdgcn_mfma_f32_16x16x32_bf16(__builtin_bit_cast(bf16x8, zb), __builtin_bit_cast(bf16x8, zb), (f32x4){0.f, 0.f, 0.f, 0.f}, 0, 0, 0); }
__device__ __forceinline__ void epi_lane(int& fr, int& fq) { unsigned ones = ~0u; asm volatile("" : "+s"(ones)); const int ln = (int)__builtin_amdgcn_mbcnt_hi(ones, __builtin_amdgcn_mbcnt_lo(ones, 0u)); fr = ln & 15; fq = ln >> 4; }
__device__ __forceinline__ void load_rs(const float* part, int row0, int fq, float (&rs)[2][4]) {
#pragma unroll
    for (int ai = 0; ai < 2; ++ai)
#pragma unroll
        for (int m = 0; m < 4; ++m) {
            const f32x4* p = (const f32x4*)(part + (size_t)(row0 + ai * HALF + m * 16) * 32 + fq * 8);
            const f32x4 a = p[0], b = p[1];
            float s = ((a[0] + a[1]) + (a[2] + a[3])) + ((b[0] + b[1]) + (b[2] + b[3]));
            s += __shfl_xor(s, 16); s += __shfl_xor(s, 32);
            rs[ai][m] = __builtin_amdgcn_rsqf(s * (1.0f / D) + EPS);
        }
}
__device__ __forceinline__ void load_rs_cached(const float* part, int pm, int row0, int wid, int fr, int fq, LAS unsigned char* lds, int& rs_pm, float (&rs)[2][4]) {
    LAS float* rc = (LAS float*)(lds + RING_BYTES) + wid * 128 + fr;
    if (pm != rs_pm) {
        load_rs(part, row0, fq, rs); rs_pm = pm;
        if (fq == 0) {
#pragma unroll
            for (int q = 0; q < 8; ++q) rc[q * 16] = rs[q >> 2][q & 3]; }
    } else {
#pragma unroll
        for (int q = 0; q < 8; ++q) rs[q >> 2][q & 3] = rc[q * 16];
    }
}
struct EpiSwiGLU {
    bf16* H; const float* part;
    __device__ __forceinline__ void operator()(f32x4 (&acc)[2][2][4][2], const Unit& u, int wr, int wc, LAS unsigned char* lds, int& rs_pm) const {
        int fr, fq; epi_lane(fr, fq);
        const int row0 = u.pm * BM + wr * 64 + fr, col0 = u.pn * HALF + wc * 32 + 8 * fq;
        float rs[2][4]; load_rs_cached(part, u.pm, row0, wr * 4 + wc, fr, fq, lds, rs_pm, rs);
        u32x4 zb = zero_frag();
#pragma unroll
        for (int ai = 0; ai < 2; ++ai)
#pragma unroll
            for (int m = 0; m < 4; ++m) {
                const float r = rs[ai][m], rsn = r * -1.4426950408889634f, rs2 = r * r; float o[8];
                f32x4 av[2], gu[2];
#pragma unroll
                for (int n = 0; n < 2; ++n) { av[n] = acc[ai][0][m][n] * rsn; gu[n] = acc[ai][0][m][n] * acc[ai][1][m][n]; }
#pragma unroll
                for (int n = 0; n < 2; ++n) { zero_acc(acc[ai][0][m][n], zb); zero_acc(acc[ai][1][m][n], zb); }
#pragma unroll
                for (int n = 0; n < 2; ++n)
#pragma unroll
                    for (int j = 0; j < 4; ++j) av[n][j] = __builtin_amdgcn_exp2f(av[n][j]);
#pragma unroll
                for (int n = 0; n < 2; ++n) av[n] = av[n] + 1.0f;
#pragma unroll
                for (int n = 0; n < 2; ++n)
#pragma unroll
                    for (int j = 0; j < 4; ++j) av[n][j] = __builtin_amdgcn_rcpf(av[n][j]);
#pragma unroll
                for (int n = 0; n < 2; ++n) { const f32x4 q = gu[n] * (av[n] * rs2);
#pragma unroll
                    for (int j = 0; j < 4; ++j) o[n * 4 + j] = q[j]; }
                u32x4 w; w.x = cvt_pk_bf16(o[0], o[1]); w.y = cvt_pk_bf16(o[2], o[3]); w.z = cvt_pk_bf16(o[4], o[5]); w.w = cvt_pk_bf16(o[6], o[7]);
                *(u32x4*)(H + (((size_t)(u.pm * (DFF / 64) + u.pn * 2 + (wc >> 1)) * BM + (wr * 64 + fr + ai * HALF + m * 16)) * 64 + (wc & 1) * 32 + 8 * fq)) = w;
            }
    }
};
struct EpiScale {
    bf16* O; int ldc; const float* part;
    __device__ __forceinline__ void operator()(f32x4 (&acc)[2][2][4][2], const Unit& u, int wr, int wc, LAS unsigned char* lds, int& rs_pm) const {
        int fr, fq; epi_lane(fr, fq);
        const int row0 = u.pm * BM + wr * 64 + fr, col0 = u.pn * BM + wc * 32 + 8 * fq;
        float rs[2][4]; load_rs_cached(part, u.pm, row0, wr * 4 + wc, fr, fq, lds, rs_pm, rs);
        u32x4 zb = zero_frag();
#pragma unroll
        for (int ai = 0; ai < 2; ++ai)
#pragma unroll
            for (int m = 0; m < 4; ++m) { const float r = rs[ai][m]; bf16* rowp = O + (size_t)(row0 + ai * HALF + m * 16) * ldc + col0;
#pragma unroll
                for (int bj = 0; bj < 2; ++bj) { const f32x4 v0 = acc[ai][bj][m][0] * r, v1 = acc[ai][bj][m][1] * r; zero_acc(acc[ai][bj][m][0], zb); zero_acc(acc[ai][bj][m][1], zb);
                    u32x4 w; w.x = cvt_pk_bf16(v0[0], v0[1]); w.y = cvt_pk_bf16(v0[2], v0[3]); w.z = cvt_pk_bf16(v1[0], v1[1]); w.w = cvt_pk_bf16(v1[2], v1[3]);
                    *(u32x4*)(rowp + bj * HALF) = w; } }
    }
};
struct EpiColScale {
    bf16* O; int ldc; const float* cs;
    __device__ __forceinline__ void operator()(f32x4 (&acc)[2][2][4][2], const Unit& u, int wr, int wc, LAS unsigned char* lds, int& rs_pm) const {
        int fr, fq; epi_lane(fr, fq);
        const int row0 = u.pm * BM + wr * 64 + fr, col0 = u.pn * BM + wc * 32 + 8 * fq;
        f32x4 sv[2][2]; u32x4 zb = zero_frag();
#pragma unroll
        for (int bj = 0; bj < 2; ++bj)
#pragma unroll
            for (int n = 0; n < 2; ++n) sv[bj][n] = *(const f32x4*)(cs + col0 + bj * HALF + 4 * n);
#pragma unroll
        for (int ai = 0; ai < 2; ++ai)
#pragma unroll
            for (int m = 0; m < 4; ++m) { bf16* rowp = O + (size_t)(row0 + ai * HALF + m * 16) * ldc + col0;
#pragma unroll
                for (int bj = 0; bj < 2; ++bj) { const f32x4 v0 = acc[ai][bj][m][0] * sv[bj][0], v1 = acc[ai][bj][m][1] * sv[bj][1]; zero_acc(acc[ai][bj][m][0], zb); zero_acc(acc[ai][bj][m][1], zb);
                    u32x4 w; w.x = cvt_pk_bf16(v0[0], v0[1]); w.y = cvt_pk_bf16(v0[2], v0[3]); w.z = cvt_pk_bf16(v1[0], v1[1]); w.w = cvt_pk_bf16(v1[2], v1[3]);
                    *(u32x4*)(rowp + bj * HALF) = w; } }
    }
};
struct EpiResid {
    bf16* xb; float* part; float alpha;
    __device__ __forceinline__ void operator()(f32x4 (&acc)[2][2][4][2], const Unit& u, int wr, int wc, LAS unsigned char* lds, int& rs_pm) const {
        int fr, fq; epi_lane(fr, fq);
        const int row0 = u.pm * BM + wr * 64 + fr, col0 = u.pn * BM + wc * 32 + 8 * fq; u32x4 zb = zero_frag();
#pragma unroll
        for (int ai = 0; ai < 2; ++ai)
#pragma unroll
            for (int m = 0; m < 4; ++m) { float ss = 0.f;
                bf16* const xrow = xb + (((size_t)(u.pm * 32 + u.pn * 4 + (wc >> 1)) * BM + (wr * 64 + fr + ai * HALF + m * 16)) * 64 + (wc & 1) * 32 + 8 * fq);
#pragma unroll
                for (int bj = 0; bj < 2; ++bj) {
                    const u32x4 xw = *(const u32x4*)(xrow + (size_t)bj * (2 * BM * 64));
                    const f32x4 x0 = (f32x4){bflo(xw.x), bfhi(xw.x), bflo(xw.y), bfhi(xw.y)}, x1 = (f32x4){bflo(xw.z), bfhi(xw.z), bflo(xw.w), bfhi(xw.w)};
                    const f32x4 v0 = x0 + acc[ai][bj][m][0] * alpha, v1 = x1 + acc[ai][bj][m][1] * alpha; zero_acc(acc[ai][bj][m][0], zb); zero_acc(acc[ai][bj][m][1], zb);
                    ss += (v0[0] * v0[0] + v0[1] * v0[1]) + (v0[2] * v0[2] + v0[3] * v0[3]) + (v1[0] * v1[0] + v1[1] * v1[1]) + (v1[2] * v1[2] + v1[3] * v1[3]);
                    u32x4 w; w.x = cvt_pk_bf16(v0[0], v0[1]); w.y = cvt_pk_bf16(v0[2], v0[3]); w.z = cvt_pk_bf16(v1[0], v1[1]); w.w = cvt_pk_bf16(v1[2], v1[3]);
                    *(u32x4*)(xrow + (size_t)bj * (2 * BM * 64)) = w; }
                ss += __shfl_xor(ss, 16); ss += __shfl_xor(ss, 32);
                if (fq == 0) part[(size_t)(row0 + ai * HALF + m * 16) * 32 + u.pn * 4 + wc] = ss;
                asm volatile("" ::: "memory"); }
    }
};
}


namespace att {
typedef short s16x4 __attribute__((ext_vector_type(4)));
constexpr int SHM_V = 64 * 128 * 2, SHM_K = 64 * 128 * 2;
#define ATT_KSWZ(row, colB) ((row) * 256 + ((colB) ^ (((row) & 7) << 4)))
__device__ __forceinline__ int crow(int r, int hi) { return (r & 3) + 8 * (r >> 2) + 4 * hi; }
__device__ __forceinline__ int v_st(int k, int c) { const int kk = (k & ~0xC) | ((k & 4) << 1) | ((k & 8) >> 1); return ((kk >> 3) * 4 + (c >> 5)) * 512 + ((kk & 7) * 32 + (c & 31)) * 2; }
__device__ __forceinline__ int v_rd_base(int lane) { return ((lane & 3) << 3) | (((lane >> 2) & 3) << 6) | (((lane >> 4) & 1) << 5) | (((lane >> 5) & 1) << 8); }
constexpr int v_rd_off(int d0, int ks, int half) { return d0 * 512 + ks * 4096 + half * 2048; }
template <int OFF> __device__ __forceinline__ s16x4 tr_read(int vb) {
    s16x4 r; asm volatile("ds_read_b64_tr_b16 %0, %1 offset:%2" : "=&v"(r) : "v"(vb), "i"(OFF) : "memory"); return r;
}
template <int D0> __device__ __forceinline__ void pv_one(f32x16& od, int vb, bf16x8 pa0, bf16x8 pa1, bf16x8 pa2, bf16x8 pa3) {
    const s16x4 l0 = tr_read<v_rd_off(D0, 0, 0)>(vb), h0 = tr_read<v_rd_off(D0, 0, 1)>(vb), l1 = tr_read<v_rd_off(D0, 1, 0)>(vb), h1 = tr_read<v_rd_off(D0, 1, 1)>(vb);
    const s16x4 l2 = tr_read<v_rd_off(D0, 2, 0)>(vb), h2 = tr_read<v_rd_off(D0, 2, 1)>(vb), l3 = tr_read<v_rd_off(D0, 3, 0)>(vb), h3 = tr_read<v_rd_off(D0, 3, 1)>(vb);
    asm volatile("s_waitcnt lgkmcnt(0)" ::: "memory"); __builtin_amdgcn_sched_barrier(0);
#define ATT_PK(L, H) (bf16x8){L[0], L[1], L[2], L[3], H[0], H[1], H[2], H[3]}
    od = __builtin_amdgcn_mfma_f32_32x32x16_bf16(pa0, ATT_PK(l0, h0), od, 0, 0, 0);
    od = __builtin_amdgcn_mfma_f32_32x32x16_bf16(pa1, ATT_PK(l1, h1), od, 0, 0, 0);
    od = __builtin_amdgcn_mfma_f32_32x32x16_bf16(pa2, ATT_PK(l2, h2), od, 0, 0, 0);
    od = __builtin_amdgcn_mfma_f32_32x32x16_bf16(pa3, ATT_PK(l3, h3), od, 0, 0, 0);
#undef ATT_PK
}
__device__ __forceinline__ int t5_bucket(int rel) { const int n = rel < 0 ? -rel : rel; int bk = rel > 0 ? 16 : 0;
    if (n < 8) bk += n; else { const int lg = (31 - __builtin_clz((unsigned)(n * n))) - 6; bk += min(8 + lg, 15); } return bk; }

__device__ __forceinline__ void attn_unit(const bf16* QKVb, bf16* AMIXb, const float* sinkp, const float* relb, int u, LAS unsigned char* lds, int tid, int lane, int wave, int& tab_key) {
    asm volatile("" : "+v"(lane));
    const int gb = u >> 3, kv = (u >> 1) & 3, hp = u & 1;
    int s0, nblk, nb; if (gb < 64) { s0 = 0; nblk = 64; nb = gb; } else { const int r = gb - 64; s0 = TP + (r >> 4) * LS; nblk = 16; nb = r & 15; }
    const int r32 = lane & 31, hi = lane >> 5, hsel = wave >> 2, qa = wave & 3, head = kv * 4 + hp * 2 + hsel;
    const int q0 = s0 + nb * 128;
    LAS unsigned char* V_lds = lds; LAS unsigned char* K_lds = lds + 2 * SHM_V;
    LAS float* wsc = (LAS float*)(lds + 2 * SHM_V + 2 * SHM_K) + wave * 64; LAS float* tab = (LAS float*)(lds + 2 * SHM_V + 2 * SHM_K + 2048);
    constexpr float LOG2E = 1.4426950408889634f, C = 0.08838834764831845f * LOG2E;
    __syncthreads();
    if ((u & 7) != tab_key) { tab_key = u & 7;
    for (int e = tid; e < 1024; e += 512) { const int hs = e >> 9, idx = e & 511, rel = idx - 255; float v = -1e30f;
        if (rel >= -128 && rel <= 128) v = relb[t5_bucket(rel) * 16 + kv * 4 + hp * 2 + hs] * LOG2E;
        tab[e] = v; } }
    const bf16* Qw = QKVb + (size_t)(q0 + qa * 32 + r32) * QKV + head * 128 + hi * 8;
    bf16x8 qr[8];
#pragma unroll
    for (int d0 = 0; d0 < 8; ++d0) qr[d0] = *(const bf16x8*)(Qw + d0 * 16);
    const int jfirst = nb > 0 ? 0 : 2, jlast = nb < nblk - 1 ? 5 : 3;
    const bf16* Kg = QKVb + 2048 + kv * 128; const bf16* Vg = QKVb + 2560 + kv * 128;
    const int sr = tid >> 4, sc = (tid & 15) * 8, vst0 = v_st(sr, sc), vst1 = v_st(32 + sr, sc);
    const int vb0 = (int)(unsigned)(uintptr_t)V_lds + v_rd_base(lane);
    bf16x8 ks0, ks1, vs0, vs1;
#define ATT_TKEY(j) (q0 + ((j) >> 1) * 128 - 128 + ((j) & 1) * 64)
#define ATT_SLOAD(j) do { const size_t k0_ = (size_t)ATT_TKEY(j); ks0 = *(const bf16x8*)(Kg + (k0_ + sr) * QKV + sc); ks1 = *(const bf16x8*)(Kg + (k0_ + 32 + sr) * QKV + sc); \
        vs0 = *(const bf16x8*)(Vg + (k0_ + sr) * QKV + sc); vs1 = *(const bf16x8*)(Vg + (k0_ + 32 + sr) * QKV + sc); } while (0)
#define ATT_SWRITE(b) do { *(LAS bf16x8*)(V_lds + (b) * SHM_V + vst0) = vs0; *(LAS bf16x8*)(V_lds + (b) * SHM_V + vst1) = vs1; \
        *(LAS bf16x8*)(K_lds + (b) * SHM_K + ATT_KSWZ(sr, sc * 2)) = ks0; *(LAS bf16x8*)(K_lds + (b) * SHM_K + ATT_KSWZ(32 + sr, sc * 2)) = ks1; } while (0)
    const float sink2 = sinkp[head] * LOG2E;
    float m_reg = sink2, l_reg = 0.f;
    f32x16 o[4];
#pragma unroll
    for (int d = 0; d < 4; ++d)
#pragma unroll
        for (int r = 0; r < 16; ++r) o[d][r] = 0.f;
    ATT_SLOAD(jfirst); asm volatile("s_waitcnt vmcnt(0)" ::: "memory"); ATT_SWRITE(0); __syncthreads();
    for (int j = jfirst; j <= jlast; ++j) {
        const int b = (j - jfirst) & 1;
        if (j < jlast) ATT_SLOAD(j + 1);
        if (!((j == 0 && qa >= 2) || (j == 5 && qa < 2))) {
        f32x16 p0, p1;
#pragma unroll
        for (int r = 0; r < 16; ++r) { p0[r] = 0.f; p1[r] = 0.f; }
        { const LAS unsigned char* Ks = K_lds + b * SHM_K;
#pragma unroll
          for (int d0 = 0; d0 < 8; ++d0) { const int cb = (d0 * 16 + hi * 8) * 2;
              const bf16x8 b0 = *(const LAS bf16x8*)(Ks + ATT_KSWZ(r32, cb)), b1 = *(const LAS bf16x8*)(Ks + ATT_KSWZ(32 + r32, cb));
              p0 = __builtin_amdgcn_mfma_f32_32x32x16_bf16(b0, qr[d0], p0, 0, 0, 0);
              p1 = __builtin_amdgcn_mfma_f32_32x32x16_bf16(b1, qr[d0], p1, 0, 0, 0); } }
        { const int koff = ((j >> 1) - 1) * 128 + (j & 1) * 64;
          const LAS float* tb = tab + hsel * 512 + (koff - (qa * 32 + r32) + 255 + 4 * hi);
#pragma unroll
          for (int r = 0; r < 16; ++r) { p0[r] = fmaf(p0[r], C, tb[(r & 3) + 8 * (r >> 2)]); p1[r] = fmaf(p1[r], C, tb[32 + (r & 3) + 8 * (r >> 2)]); } }
        float pmax = p0[0];
#pragma unroll
        for (int r = 1; r < 16; ++r) pmax = fmaxf(pmax, p0[r]);
#pragma unroll
        for (int r = 0; r < 16; ++r) pmax = fmaxf(pmax, p1[r]);
        { auto rr = __builtin_amdgcn_permlane32_swap(__float_as_uint(pmax), __float_as_uint(pmax), false, false); pmax = fmaxf(__uint_as_float(rr[0]), __uint_as_float(rr[1])); }
        const float mn = fmaxf(m_reg, pmax), alpha = __builtin_amdgcn_exp2f(m_reg - mn); m_reg = mn;
        float ps = 0.f;
#pragma unroll
        for (int r = 0; r < 16; ++r) { p0[r] = __builtin_amdgcn_exp2f(p0[r] - mn); p1[r] = __builtin_amdgcn_exp2f(p1[r] - mn); ps += p0[r] + p1[r]; }
        { auto rr = __builtin_amdgcn_permlane32_swap(__float_as_uint(ps), __float_as_uint(ps), false, false); ps = __uint_as_float(rr[0]) + __uint_as_float(rr[1]); }
        l_reg = l_reg * alpha + ps;
        if (__any(alpha < 1.f)) { if (hi == 0) wsc[r32] = alpha; asm volatile("s_waitcnt lgkmcnt(0)" ::: "memory");
#pragma unroll
            for (int r = 0; r < 16; ++r) { const float al = wsc[crow(r, hi)];
#pragma unroll
                for (int d = 0; d < 4; ++d) o[d][r] *= al; }
            asm volatile("s_waitcnt lgkmcnt(0)" ::: "memory"); }
        bf16x8 pa0, pa1, pa2, pa3;
#define ATT_PK4(P, BASE, OUT) do { unsigned a0 = cvt_pk_bf16(P[BASE + 0], P[BASE + 1]), a1 = cvt_pk_bf16(P[BASE + 2], P[BASE + 3]);   \
        unsigned b0 = cvt_pk_bf16(P[BASE + 4], P[BASE + 5]), b1 = cvt_pk_bf16(P[BASE + 6], P[BASE + 7]);                              \
        auto r0 = __builtin_amdgcn_permlane32_swap(a0, b0, false, false); auto r1 = __builtin_amdgcn_permlane32_swap(a1, b1, false, false); \
        u32x4 w = {r0[0], r1[0], r0[1], r1[1]}; OUT = __builtin_bit_cast(bf16x8, w); } while (0)
        ATT_PK4(p0, 0, pa0); ATT_PK4(p0, 8, pa1); ATT_PK4(p1, 0, pa2); ATT_PK4(p1, 8, pa3);
#undef ATT_PK4
        { const int vb = vb0 + b * SHM_V;
          pv_one<0>(o[0], vb, pa0, pa1, pa2, pa3); pv_one<1>(o[1], vb, pa0, pa1, pa2, pa3); pv_one<2>(o[2], vb, pa0, pa1, pa2, pa3); pv_one<3>(o[3], vb, pa0, pa1, pa2, pa3); }
        }
        if (j < jlast) { asm volatile("s_waitcnt vmcnt(0)" ::: "memory"); ATT_SWRITE(b ^ 1); }
        __syncthreads();
    }
    l_reg += __builtin_amdgcn_exp2f(sink2 - m_reg);
    if (hi == 0) wsc[r32] = l_reg; asm volatile("s_waitcnt lgkmcnt(0)" ::: "memory");
    bf16* Ow = AMIXb + (size_t)(q0 + qa * 32) * D + head * 128 + r32;
#pragma unroll
    for (int r = 0; r < 16; ++r) { const int orow = crow(r, hi); const float rl = __builtin_amdgcn_rcpf(wsc[orow]);
#pragma unroll
        for (int d0 = 0; d0 < 4; ++d0) Ow[(size_t)orow * D + d0 * 32] = (bf16)f2bf(o[d0][r] * rl); }
    asm volatile("s_waitcnt lgkmcnt(0)" ::: "memory");
#undef ATT_TKEY
#undef ATT_SLOAD
#undef ATT_SWRITE
}
}

struct Args { const float* in[30]; float* out; unsigned char* ws; int ph_lo, ph_hi; };
typedef const Args __attribute__((address_space(4)))* KArgs;
enum { I_XP = 0, I_XS, I_NF1, I_F1WI, I_F1WO, I_NMIX, I_ABIN, I_POOLW, I_POOLS, I_HCW, I_HCB, I_HW1, I_HB1, I_HW2, I_HB2, I_HW3, I_HB3, I_HW4, I_HB4, I_HFREQ, I_HD,
       I_ABOUT, I_WQKV, I_WO, I_SINK, I_RELB, I_NF2, I_F2WI, I_F2WO, I_NFIN };

struct Mat { const float* src; const float* gain; bf16* dst; int K, N, srcN, swi, tiled; };
constexpr int NMAT = 34;
__device__ __forceinline__ Mat get_mat(KArgs a, int mi) {
    Mat m; m.gain = nullptr; m.swi = 0; m.tiled = 1;
    unsigned char* ws = a->ws;
    if (mi < 16) { const int l = mi >> 2, w = mi & 3; unsigned char* fb = ws + WS_W + (size_t)(l * 2 + (w >> 1)) * SZ_FFN;
        if ((w & 1) == 0) { m.src = a->in[(w >> 1) ? I_F2WI : I_F1WI] + (size_t)l * D * 2 * DFF; m.gain = a->in[(w >> 1) ? I_NF2 : I_NF1] + l * D; m.dst = (bf16*)fb; m.K = D; m.N = 2 * DFF; m.srcN = 2 * DFF; m.swi = 1; }
        else { m.src = a->in[(w >> 1) ? I_F2WO : I_F1WO] + (size_t)l * DFF * D; m.dst = (bf16*)(fb + SZ_WI); m.K = DFF; m.N = D; m.srcN = D; }
        return m; }
    mi -= 16;
    if (mi < 10) { const int i = mi / 5, w = mi % 5; unsigned char* mb = ws + WS_WMIX + (size_t)i * SZ_MIX;
        if (w == 0) { m.src = a->in[I_ABIN] + (size_t)i * D * ABIN; m.gain = a->in[I_NMIX] + (2 * i) * D; m.dst = (bf16*)mb; m.K = D; m.N = ABIN; m.srcN = ABIN; }
        else if (w == 1) { m.src = a->in[I_ABOUT] + (size_t)i * D * D; m.dst = (bf16*)(mb + SZ_ABIN); m.K = D; m.N = D; m.srcN = D; }
        else if (w == 2) { m.src = a->in[I_WQKV] + (size_t)i * D * QKV; m.gain = a->in[I_NMIX] + (2 * i + 1) * D; m.dst = (bf16*)(mb + SZ_ABIN + SZ_DD + SZ_POOL); m.K = D; m.N = QKV; m.srcN = QKV; }
        else if (w == 3) { m.src = a->in[I_WO] + (size_t)i * D * D; m.dst = (bf16*)(mb + SZ_ABIN + SZ_DD + SZ_POOL + SZ_QKV); m.K = D; m.N = D; m.srcN = D; }
        else { m.src = a->in[I_POOLW] + (size_t)i * 4 * 65536; m.dst = (bf16*)(mb + SZ_ABIN + SZ_DD); m.K = 256; m.N = 256; m.srcN = 256; m.tiled = 0; }
        return m; }
    mi -= 10;
    { const int i = mi / 3, gq = 1 + mi % 3; unsigned char* mb = ws + WS_WMIX + (size_t)i * SZ_MIX;
      m.src = a->in[I_POOLW] + (size_t)(i * 4 + gq) * 65536; m.dst = (bf16*)(mb + SZ_ABIN + SZ_DD) + (size_t)gq * 65536; m.K = 256; m.N = 256; m.srcN = 256; m.tiled = 0; }
    return m;
}
constexpr int NMAT_USED = 32;

__device__ __forceinline__ void cvt_item(const Mat& mt, int item, int lane) {
    const int nblk = mt.N / 64, kb = item / nblk, nb = item % nblk, k0 = 64 * kb, n0 = 64 * nb;
    int s0 = n0;
    if (mt.swi) { const int pn = n0 >> 8, half = (n0 >> 7) & 1, jj = n0 & 127; s0 = half * DFF + 128 * pn + jj; }
    const int kg = lane >> 4, nq = lane & 15;
    const float* src = mt.src + (size_t)(k0 + 16 * kg) * mt.srcN + s0 + 4 * nq;
    f32x4 v[16];
#pragma unroll
    for (int i = 0; i < 16; ++i) v[i] = *(const f32x4*)(src + (size_t)i * mt.srcN);
    if (mt.gain) { const f32x4* g4 = (const f32x4*)(mt.gain + k0 + 16 * kg);
#pragma unroll
        for (int q = 0; q < 4; ++q) { const f32x4 g = g4[q];
#pragma unroll
            for (int x = 0; x < 4; ++x) v[4 * q + x] = v[4 * q + x] * g[x]; } }
    const size_t rstep = mt.tiled ? (size_t)64 : (size_t)mt.K;
    bf16* dst = mt.tiled ? mt.dst + (((size_t)(nb >> 2) * (size_t)(mt.K / 64) + kb) * 256 + (nb & 3) * 64 + 4 * nq) * 64 + 16 * kg
                         : mt.dst + (size_t)(n0 + 4 * nq) * mt.K + k0 + 16 * kg;
#pragma unroll
    for (int e = 0; e < 4; ++e)
#pragma unroll
        for (int h = 0; h < 2; ++h) { u32x4 o;
            o.x = cvt_pk_bf16(v[8 * h + 0][e], v[8 * h + 1][e]); o.y = cvt_pk_bf16(v[8 * h + 2][e], v[8 * h + 3][e]);
            o.z = cvt_pk_bf16(v[8 * h + 4][e], v[8 * h + 5][e]); o.w = cvt_pk_bf16(v[8 * h + 6][e], v[8 * h + 7][e]);
            *(u32x4*)(dst + (size_t)e * rstep + 8 * h) = o; }
}


__device__ __forceinline__ int mat_slot(int mi) {
    return 0;
    if (mi < 16) { const int l = mi >> 2, w = mi & 3; return l == 0 ? 0 : (l == 1 ? 1 : (l == 2 ? (w < 2 ? 0 : 2) : 2)); }
    if (mi < 26) { const int i = (mi - 16) / 5, w = (mi - 16) % 5; if (i == 0) return (w == 2 || w == 3) ? 1 : 0; return w == 0 ? 0 : ((w == 1 || w == 4) ? 1 : 2); }
    return mi < 29 ? 0 : 1;
}
__device__ __forceinline__ void cvt_slot(KArgs ka, int slot, int wv, int nw, int lane) {
    int mi = -1; Mat mt; long base = 0; int cnt = 0;
    for (long it = wv; ; it += nw) {
        while (it >= base + cnt) { base += cnt; cnt = 0; do { ++mi; } while (mi < NMAT_USED && mat_slot(mi) != slot); if (mi >= NMAT_USED) break; mt = get_mat(ka, mi); cnt = (mt.K / 64) * (mt.N / 64); }
        if (mi >= NMAT_USED) break;
        cvt_item(mt, (int)(it - base), lane);
    }
}

__device__ __forceinline__ void filter_job(KArgs a, int jb, LAS float* sm, int tid) {
    const int i = jb / 320, r = jb % 320, lsel = r < 256 ? 0 : 1, tile = lsel ? r - 256 : r, L = lsel ? LS : TP, j0 = tile * 32;
    LAS float* zb = sm; LAS float* ha = sm + 32 * 36; LAS float* hb = ha + 32 * 64;
    const float* w1 = a->in[I_HW1] + i * 33 * 64; const float* b1 = a->in[I_HB1] + i * 64; const float* w2 = a->in[I_HW2] + i * 4096; const float* b2 = a->in[I_HB2] + i * 64;
    const float* w3 = a->in[I_HW3] + i * 4096; const float* b3 = a->in[I_HB3] + i * 64; const float* w4 = a->in[I_HW4] + (size_t)i * 64 * 2048; const float* b4 = a->in[I_HB4] + i * 2048;
    const float* fq = a->in[I_HFREQ] + i * 64;
    const int jj = tid >> 4, og = tid & 15;
    { const int j = j0 + jj; const float wj = 6.283185307179586f * (float)j / (float)L; const float fb = 1e-4f + (float)og * ((15.0f - 1e-4f) / 15.0f); const float ang = fb * wj;
      zb[jj * 36 + 1 + og] = cosf(ang); zb[jj * 36 + 17 + og] = -sinf(ang); if (og == 0) zb[jj * 36] = (float)j / (float)(L - 1); }
    __syncthreads();
    { float acc[4];
#pragma unroll
      for (int q = 0; q < 4; ++q) acc[q] = b1[og * 4 + q];
#pragma unroll 3
      for (int e = 0; e < 33; ++e) { const float z = zb[jj * 36 + e]; const f32x4 w = *(const f32x4*)(w1 + e * 64 + og * 4);
#pragma unroll
          for (int q = 0; q < 4; ++q) acc[q] += z * w[q]; }
#pragma unroll
      for (int q = 0; q < 4; ++q) ha[jj * 64 + og * 4 + q] = sinf(fq[og * 4 + q] * acc[q]); }
    __syncthreads();
    { float acc[4];
#pragma unroll
      for (int q = 0; q < 4; ++q) acc[q] = b2[og * 4 + q];
#pragma unroll 4
      for (int e = 0; e < 64; ++e) { const float z = ha[jj * 64 + e]; const f32x4 w = *(const f32x4*)(w2 + e * 64 + og * 4);
#pragma unroll
          for (int q = 0; q < 4; ++q) acc[q] += z * w[q]; }
#pragma unroll
      for (int q = 0; q < 4; ++q) hb[jj * 64 + og * 4 + q] = sinf(fq[og * 4 + q] * acc[q]); }
    __syncthreads();
    { float acc[4];
#pragma unroll
      for (int q = 0; q < 4; ++q) acc[q] = b3[og * 4 + q];
#pragma unroll 4
      for (int e = 0; e < 64; ++e) { const float z = hb[jj * 64 + e]; const f32x4 w = *(const f32x4*)(w3 + e * 64 + og * 4);
#pragma unroll
          for (int q = 0; q < 4; ++q) acc[q] += z * w[q]; }
#pragma unroll
      for (int q = 0; q < 4; ++q) ha[jj * 64 + og * 4 + q] = sinf(fq[og * 4 + q] * acc[q]); }
    __syncthreads();
    const int c4 = tid * 4, ch = c4 & 1023; const bool isb = c4 >= 1024;
    bf16* KT = (bf16*)(a->ws + WS_KT + (size_t)i * SZ_KT1 + (lsel ? (size_t)2 * TP * 1024 * 2 : 0));
    float* kp = (float*)(a->ws + WS_KPART) + ((size_t)i * 320 + r) * 2048;
    const float dmin = -3.0701134573253945f, dmax = -15.350567286626973f;
    float ad[4];
#pragma unroll
    for (int q = 0; q < 4; ++q) ad[q] = fabsf(dmin + (float)(ch + q) * ((dmax - dmin) / 1023.0f));
    const f32x4 bias = *(const f32x4*)(b4 + c4);
    float asum[4] = {0.f, 0.f, 0.f, 0.f};
    for (int grp = 0; grp < 4; ++grp) {
        float acc[8][4];
#pragma unroll
        for (int q = 0; q < 8; ++q)
#pragma unroll
            for (int x = 0; x < 4; ++x) acc[q][x] = bias[x];
#pragma unroll 8
        for (int k = 0; k < 64; ++k) { const f32x4 w = *(const f32x4*)(w4 + (size_t)k * 2048 + c4);
#pragma unroll
            for (int q = 0; q < 8; ++q) { const float hv = ha[(grp * 8 + q) * 64 + k];
#pragma unroll
                for (int x = 0; x < 4; ++x) acc[q][x] += hv * w[x]; } }
#pragma unroll
        for (int q = 0; q < 8; ++q) { const int j = j0 + grp * 8 + q; const float tj = (float)j / (float)(L - 1); float v[4];
#pragma unroll
            for (int x = 0; x < 4; ++x) v[x] = acc[q][x] * expf(-tj * ad[x]);
            if (!(isb && j == 0)) {
#pragma unroll
                for (int x = 0; x < 4; ++x) asum[x] += fabsf(v[x]);
                const int m = isb ? L - j : L + j;
                u32x2 w; w.x = pk2(v[0], v[1]); w.y = pk2(v[2], v[3]);
                *(u32x2*)(KT + (size_t)m * 1024 + ch) = w; } }
    }
    *(f32x4*)(kp + c4) = (f32x4){asum[0], asum[1], asum[2], asum[3]};
    if (tile == 0 && tid < 256) *(u32x2*)(KT + tid * 4) = (u32x2){0u, 0u};
    __syncthreads();
}


__device__ __forceinline__ void r_transpose_tile(const bf16* KTb, bf16* Rb, int L, int tile, LAS unsigned short* sm, int tid) {
    const int mb = tile >> 4, cb = tile & 15, m0 = mb * 64, c0 = cb * 64;
    { const int mr = tid >> 3, cq = tid & 7; const u32x4 v = *(const u32x4*)(KTb + (size_t)(m0 + mr) * 1024 + c0 + 8 * cq);
      LAS unsigned* d = (LAS unsigned*)(sm + mr * 66 + 8 * cq); d[0] = v.x; d[1] = v.y; d[2] = v.z; d[3] = v.w; }
    __syncthreads();
    { const int cc = tid >> 3, mq = tid & 7; bf16* rrow = Rb + (size_t)(c0 + cc) * 2 * L;
#pragma unroll
      for (int k = 0; k < 8; ++k) { const int mm = mq + 8 * k, m = m0 + mm; const unsigned short val = sm[mm * 66 + cc];
          if (m == 0) rrow[0] = 0; else rrow[2 * L - m] = val; } }
    __syncthreads();
}

template <int RHO> __device__ __forceinline__ bf16x8 shift_frag(const u32x4& c0, const u32x4& c1) {
    const unsigned w[8] = {c0.x, c0.y, c0.z, c0.w, c1.x, c1.y, c1.z, c1.w}; u32x4 o;
    if constexpr ((RHO & 1) == 0) { o.x = w[RHO / 2]; o.y = w[RHO / 2 + 1]; o.z = w[RHO / 2 + 2]; o.w = w[RHO / 2 + 3]; }
    else { constexpr int b = RHO / 2; o.x = __builtin_amdgcn_alignbit(w[b + 1], w[b], 16); o.y = __builtin_amdgcn_alignbit(w[b + 2], w[b + 1], 16);
           o.z = __builtin_amdgcn_alignbit(w[b + 3], w[b + 2], 16); o.w = __builtin_amdgcn_alignbit(w[b + 4], w[b + 3], 16); }
    return __builtin_bit_cast(bf16x8, o);
}

typedef unsigned u32x4a4 __attribute__((ext_vector_type(4), aligned(4)));
template <bool PROMPT, int HALF>
__device__ __forceinline__ void conv_item(unsigned char* ws, KArgs ka, int ib, int oct, int g, LAS unsigned char* lds, int tid, int lane, int wave) {
    constexpr int L = PROMPT ? TP : LS;
    { unsigned ones_ = ~0u; asm volatile("" : "+s"(ones_)); lane = (int)__builtin_amdgcn_mbcnt_hi(ones_, __builtin_amdgcn_mbcnt_lo(ones_, 0u)); }
    const int c = oct * 8 + wave, c0 = oct * 8;
    const bf16* Rc = (const bf16*)(ws + WS_R) + (PROMPT ? (size_t)0 : (size_t)2 * TP * 1024) + (size_t)c * 2 * L + L;
    const int nn = lane & 15, kq = lane >> 4;
    const int xa = 8 * kq - 2 * nn;
    LAS unsigned char* vl = lds + wave * (33 * 528);
    { const bf16* Vg = (const bf16*)(ws + WS_VVT) + (size_t)c * T + (PROMPT ? 0 : TP + 4 * g * LS);
      __syncthreads();
#pragma unroll 4
      for (int it = 0; it < 16; ++it) { const int s_ = (it * 64 + lane) * 8; *(LAS u32x4*)(vl + (s_ >> 8) * 528 + (s_ & 255) * 2) = *(const u32x4*)(Vg + s_); }
      unsigned zz_ = 0u; asm volatile("" : "+v"(zz_));
      if (lane < 33) *(LAS u32x4*)(vl + 32 * 528 + lane * 16) = (u32x4){zz_, zz_, zz_, zz_}; }
    constexpr int NB = PROMPT ? 32 : 8, GS = PROMPT ? 16 : 4;
    const int nbv = PROMPT ? nn : (nn >> 2);
    LAS unsigned char* vcol = vl + 16 * kq + (PROMPT ? 0 : 8 * (nn & 3)) * 528;
    const int zrow = PROMPT ? 32 : 32 - 8 * (nn & 3);
    constexpr int W = (HALF == 2) ? 8 : 4, MO = (HALF == 1) ? 4 : 0;
    f32x4 acc[2][W][2];
#pragma unroll
    for (int r = 0; r < 2; ++r)
#pragma unroll
        for (int q = 0; q < W; ++q)
#pragma unroll
            for (int gg = 0; gg < 2; ++gg) acc[r][q][gg] = (f32x4){0.f, 0.f, 0.f, 0.f};
    constexpr int E0 = PROMPT ? -255 : -63, E1 = PROMPT ? -135 : -39, E2 = PROMPT ? 129 : 33, E3 = PROMPT ? 257 : 65;
    static_assert((E1 - E0) % 8 == 0 && (E2 - E1) % 8 == 0 && (E3 - E2) % 8 == 0, "segments are whole 8-step blocks");
    constexpr int DA = (HALF == 2) ? 2 : 4;
    u32x4 rh[DA]; unsigned rl[DA];
    u32x4 F0[W], F1[W];
#define CONV_LOADA(e_, k_) do { const int xh_ = min(32 * (e_) + xa, L - 8); rh[k_] = *(const u32x4a4*)(Rc + xh_); asm volatile("" ::: "memory"); rl[k_] = *(const unsigned*)(Rc + xh_ - 2); } while (0)
#define CONV_LDF(m_, gsel_, dst_) do { const int rr_ = nbv + (gsel_) * GS + ((m_) >> 3); const int row_ = ((unsigned)rr_ < (unsigned)NB) ? rr_ : zrow; \
        dst_ = *(const LAS u32x4*)(vcol + row_ * 528 + 64 * ((m_) & 7)); } while (0)
#define CONV_MM(r0_, q_, gg_, a_, f_) acc[r0_][q_][gg_] = __builtin_amdgcn_mfma_f32_16x16x32_bf16(a_, __builtin_bit_cast(bf16x8, f_), acc[r0_][q_][gg_], 0, 0, 0)
#define CONV_STEP(j, DO0, DO1) do { const int ee_ = e + (j); \
        const u32x4 ah_ = rh[(j) % DA]; const unsigned al_ = rl[(j) % DA]; \
        CONV_LOADA(ee_ + DA, (j) % DA); \
        asm volatile("" ::: "memory"); \
        u32x4 as_; as_.x = __builtin_amdgcn_alignbit(ah_.x, al_, 16); as_.y = __builtin_amdgcn_alignbit(ah_.y, ah_.x, 16); as_.z = __builtin_amdgcn_alignbit(ah_.z, ah_.y, 16); as_.w = __builtin_amdgcn_alignbit(ah_.w, ah_.z, 16); \
        const bf16x8 a0_ = __builtin_bit_cast(bf16x8, ah_), a1_ = __builtin_bit_cast(bf16x8, as_); \
        __builtin_amdgcn_s_setprio(1); \
        if (DO0) { CONV_MM(0, 0, 0, a0_, F0[(j) % W]); CONV_MM(1, 0, 0, a1_, F0[(j) % W]); } \
        if (DO1) { CONV_MM(0, 0, 1, a0_, F1[(j) % W]); CONV_MM(1, 0, 1, a1_, F1[(j) % W]); } \
        if (DO0) CONV_LDF(ee_ + MO + W, 0, F0[(j) % W]); \
        if (DO1) CONV_LDF(ee_ + MO + W, 1, F1[(j) % W]); \
        _Pragma("unroll") for (int q_ = 1; q_ < W; ++q_) { \
            if (DO0) { CONV_MM(0, q_, 0, a0_, F0[((j) + q_) % W]); CONV_MM(1, q_, 0, a1_, F0[((j) + q_) % W]); } \
            if (DO1) { CONV_MM(0, q_, 1, a0_, F1[((j) + q_) % W]); CONV_MM(1, q_, 1, a1_, F1[((j) + q_) % W]); } } \
        __builtin_amdgcn_s_setprio(0); \
        __builtin_amdgcn_sched_barrier(0); } while (0)
#define CONV_BLOCK(DO0, DO1) do { CONV_STEP(0, DO0, DO1); CONV_STEP(1, DO0, DO1); CONV_STEP(2, DO0, DO1); CONV_STEP(3, DO0, DO1); CONV_STEP(4, DO0, DO1); CONV_STEP(5, DO0, DO1); CONV_STEP(6, DO0, DO1); CONV_STEP(7, DO0, DO1); } while (0)
#pragma unroll
    for (int k = 0; k < DA; ++k) CONV_LOADA(E0 + k, k);
    { unsigned zz_ = 0u; asm volatile("" : "+v"(zz_));
#pragma unroll
      for (int k = 0; k < W; ++k) F1[k] = (u32x4){zz_, zz_, zz_, zz_}; }
    for (int e = E0; e < E1; e += 8) CONV_BLOCK(false, true);
    { unsigned zz_ = 0u; asm volatile("" : "+v"(zz_));
#pragma unroll
      for (int k = 0; k < W; ++k) F0[k] = (u32x4){zz_, zz_, zz_, zz_}; }
    for (int e = E1; e < E2; e += 8) CONV_BLOCK(true, true);
    for (int e = E2; e < E3; e += 8) CONV_BLOCK(true, false);
#undef CONV_BLOCK
#undef CONV_STEP
#undef CONV_MM
#undef CONV_LDF
#undef CONV_LOADA
    __syncthreads();
    int lane2; { unsigned ones_ = ~0u; asm volatile("" : "+s"(ones_)); lane2 = (int)__builtin_amdgcn_mbcnt_hi(ones_, __builtin_amdgcn_mbcnt_lo(ones_, 0u)); }
    const int nn2 = lane2 & 15, kq2 = lane2 >> 4;
    float nsum = 0.f;
    { const float* kq_ = (const float*)(ws + WS_KPART) + ((size_t)ib * 320 + (PROMPT ? 0 : 256)) * 2048; constexpr int ntile = PROMPT ? 256 : 64;
      for (int q = lane2; q < ntile; q += 64) nsum += kq_[(size_t)q * 2048 + c] + kq_[(size_t)q * 2048 + 1024 + c];
      nsum = wave_sum(nsum); }
    const float inv = 1.0f / nsum;
    LAS float* stage = (LAS float*)lds;
    const int tid2 = wave * 64 + lane2;
    const float* dbias = ka->in[I_HD] + ib * 1024 + c0;
    const bf16* X0B = (const bf16*)(ws + WS_X0); const bf16* VVB = (const bf16*)(ws + WS_VV); bf16* AMIX = (bf16*)(ws + WS_AMIX);
#pragma unroll
    for (int h = 0; h < 2; ++h) {
        if (HALF != 2 && h != HALF) continue;
#pragma unroll
        for (int rp = 0; rp < 4; ++rp)
#pragma unroll
            for (int r0 = 0; r0 < 2; ++r0)
#pragma unroll
                for (int gg = 0; gg < 2; ++gg)
#pragma unroll
                    for (int j = 0; j < 4; ++j) { const int tl = 32 * rp + 2 * (4 * kq2 + j) + r0; stage[wave * 4096 + tl * 32 + 16 * gg + nn2] = acc[r0][(HALF == 2 ? 4 * h : 0) + rp][gg][j] * inv; }
        __syncthreads();
        float db[8];
#pragma unroll
        for (int q = 0; q < 8; ++q) db[q] = dbias[q];
#pragma unroll 2
        for (int k = 0; k < 8; ++k) { const int row = tid2 + 512 * k, n = row & 31, tl = row >> 5;
            int t; if (PROMPT) t = 256 * n + 128 * h + tl; else t = TP + (4 * g + (n & 3)) * LS + 256 * (n >> 2) + 128 * h + tl;
            float y[8];
#pragma unroll
            for (int q = 0; q < 8; ++q) y[q] = stage[q * 4096 + row];
            const u32x4 xv = *(const u32x4*)(X0B + (size_t)t * 1024 + c0), vv = *(const u32x4*)(VVB + (size_t)t * 1024 + c0);
            u32x4 o;
            o.x = pk2((y[0] + bflo(vv.x) * db[0]) * bflo(xv.x), (y[1] + bfhi(vv.x) * db[1]) * bfhi(xv.x));
            o.y = pk2((y[2] + bflo(vv.y) * db[2]) * bflo(xv.y), (y[3] + bfhi(vv.y) * db[3]) * bfhi(xv.y));
            o.z = pk2((y[4] + bflo(vv.z) * db[4]) * bflo(xv.z), (y[5] + bfhi(vv.z) * db[5]) * bfhi(xv.z));
            o.w = pk2((y[6] + bflo(vv.w) * db[6]) * bflo(xv.w), (y[7] + bfhi(vv.w) * db[7]) * bfhi(xv.w));
            *(u32x4*)(AMIX + (size_t)t * D + 1024 + c0) = o; }
        __syncthreads();
    }
}

__device__ __forceinline__ void seq_of(int t, int& s0, int& L) { if (t < TP) { s0 = 0; L = TP; } else { s0 = TP + ((t - TP) / LS) * LS; L = LS; } }

__global__ void __launch_bounds__(512, 2) fwd_kernel(Args args) {
    extern __shared__ __attribute__((aligned(16))) unsigned char lds_raw[];
    LAS unsigned char* lds = (LAS unsigned char*)lds_raw;
    const int tid0 = threadIdx.x; const int wave0 = __builtin_amdgcn_readfirstlane(tid0 >> 6);
    const int G = gridDim.x, NGW = G * 8;
#define PHASE_IDS unsigned ones_ = ~0u; asm volatile("" : "+s"(ones_)); const int lane = (int)__builtin_amdgcn_mbcnt_hi(ones_, __builtin_amdgcn_mbcnt_lo(ones_, 0u)); const int wave = wave0, tid = wave * 64 + lane, gw = blockIdx.x * 8 + wave; (void)tid; (void)lane; (void)gw; KArgs ka = (KArgs)__builtin_amdgcn_kernarg_segment_ptr(); asm volatile("" : "+s"(ka)); unsigned char* const ws = ka->ws; (void)ws; \
    bf16* const XB = (bf16*)(ws + WS_XB); bf16* const HB = (bf16*)(ws + WS_H); bf16* const AMIX = (bf16*)(ws + WS_AMIX); bf16* const PB = (bf16*)(ws + WS_P); bf16* const X0B = (bf16*)(ws + WS_X0); bf16* const VVB = (bf16*)(ws + WS_VV); \
    float* const PART = (float*)(ws + WS_PART); float* const OUT = ka->out; (void)XB; (void)HB; (void)AMIX; (void)PB; (void)X0B; (void)VVB; (void)PART; (void)OUT;
    unsigned char* ws0 = args.ws;
    volatile LAS unsigned* MISC = (volatile LAS unsigned*)(lds + MISC_OFF);
    if (tid0 < 64) MISC[tid0] = 0u;
    __syncthreads();
    XcdBarrier bar; bar.bar = (unsigned*)(ws0 + WS_CTL) + 4096; bar.x = 0; bar.st = MISC + 8;
#if !MK_PER_PHASE
    bar = xcd_barrier_post((unsigned*)(ws0 + WS_CTL) + 4096, MISC + 8);
#endif
    const int lo = args.ph_lo, hi = args.ph_hi;
#define RUN(k) (lo <= (k) && (k) < hi)
#if MK_PER_PHASE
#define SEAM(k) do { } while (0)
#else
#define SEAM(k) do { if (RUN(k) && RUN((k) + 1)) xcd_barrier(bar); } while (0)
#endif
    int ph = 0;

    if (RUN(ph)) { PHASE_IDS
        for (int step = 0; step < 2; ++step) {
            if ((step == 0) != ((blockIdx.x & 1) != 0)) {
                for (int jb = blockIdx.x; jb < 640; jb += G) filter_job(ka, jb, (LAS float*)lds, tid);
            } else {
        for (int m = gw; m < T; m += NGW) {
            const float* xr = (m < TP) ? ka->in[I_XP] + (size_t)m * D : ka->in[I_XS] + (size_t)(m - TP) * D;
            const f32x4* x4 = (const f32x4*)xr + lane; float ss = 0.f; u32x2* o = (u32x2*)(XB + ((size_t)(m >> 8) * (32 * 256) + (size_t)(lane >> 4) * 256 + (m & 255)) * 64 + 4 * (lane & 15));
#pragma unroll
            for (int j = 0; j < 8; ++j) { const f32x4 v = x4[64 * j]; ss += (v[0] * v[0] + v[1] * v[1]) + (v[2] * v[2] + v[3] * v[3]); o[(size_t)j * (4 * 256 * 64 / 4)] = (u32x2){pk2(v[0], v[1]), pk2(v[2], v[3])}; }
            ss = wave_sum(ss);
            if (lane < 32) PART[(size_t)m * 32 + lane] = lane == 0 ? ss : 0.f;
        }
        cvt_slot(ka, 0, gw, NGW, lane);
            }
        }
    }
    SEAM(ph); ++ph;

    for (int l = 0; l < 4; ++l) {
        const int ib = l >> 1;
        for (int f = 0; f < 3; ++f) {
            if (f != 1) {
                if (RUN(ph)) { PHASE_IDS
                    unsigned char* fw = ws + WS_W + (size_t)(l * 2 + (f >> 1)) * SZ_FFN; pg8::Gemm g{XB, (const bf16*)fw, T, 2 * DFF, D, 64, 64, 0, 256 * 64 * 2, 256 * 64 * 2}; pg8::StaticOrder S; S.init(T, 2 * DFF, G, (int)blockIdx.x);
                    pg8::EpiSwiGLU E{HB, PART};
                    pg8::gemm_phase<pg8::EpiSwiGLU, true>(lds, g, S, E, tid);
                }
                SEAM(ph); ++ph;
                if (RUN(ph)) { PHASE_IDS
                    unsigned char* fw = ws + WS_W + (size_t)(l * 2 + (f >> 1)) * SZ_FFN; pg8::Gemm g{HB, (const bf16*)(fw + SZ_WI), T, D, DFF, 64, 64, 0, 256 * 64 * 2, 256 * 64 * 2}; pg8::StaticOrder S; S.init(T, D, G, (int)blockIdx.x, 1);
                    pg8::EpiResid E{XB, PART, 0.5f};
                    pg8::gemm_phase<pg8::EpiResid, true>(lds, g, S, E, tid);
                }
                SEAM(ph); ++ph;
            } else {
                const bool even = (l & 1) == 0;
                if (RUN(ph)) { PHASE_IDS
                    const int N = even ? ABIN : QKV; unsigned char* mixw = ws + WS_WMIX + (size_t)ib * SZ_MIX;
                    pg8::Gemm g{XB, (const bf16*)(even ? mixw : mixw + SZ_ABIN + SZ_DD + SZ_POOL), T, N, D, 64, 64, 0, 256 * 64 * 2, 256 * 64 * 2}; pg8::StaticOrder S; S.init(T, N, G, (int)blockIdx.x);
                    pg8::EpiScale E{HB, N, PART};
                    pg8::gemm_phase<pg8::EpiScale, true>(lds, g, S, E, tid);
                }
                SEAM(ph); ++ph;
                if (even) {
                    if (RUN(ph)) { PHASE_IDS
                        { const bf16* KT0 = (const bf16*)(ws + WS_KT + (size_t)ib * SZ_KT1); bf16* R0 = (bf16*)(ws + WS_R);
                          for (int tile = blockIdx.x; tile < 5120; tile += G) {
                              if (tile < 4096) r_transpose_tile(KT0, R0, TP, tile, (LAS unsigned short*)lds, tid);
                              else r_transpose_tile(KT0 + (size_t)2 * TP * 1024, R0 + (size_t)2 * TP * 1024, LS, tile - 4096, (LAS unsigned short*)lds, tid); } }
                        const float* cw = ka->in[I_HCW] + (size_t)ib * 3 * 3072; const float* cb = ka->in[I_HCB] + (size_t)ib * 3072;
                        bf16* VVT = (bf16*)(ws + WS_VVT);
                        LAS unsigned* vvl = (LAS unsigned*)lds;
                        for (int tile = blockIdx.x; tile < T / 32; tile += G) {
                          const int tok0 = tile * 32; int s0, L; seq_of(tok0, s0, L);
                          {
                            const int gq = wave & 3, th = wave >> 2, ck = gq * 32 + (lane & 31), c = ck * 8, tlocA = 16 * th + 8 * (lane >> 5), tA = tok0 + tlocA, tlA = tA - s0;
                            const u32x4 z = (u32x4){0u, 0u, 0u, 0u};
                            { const int hw = 1 << gq; float S[8] = {0, 0, 0, 0, 0, 0, 0, 0};
                              const bf16* ua = HB + (size_t)s0 * ABIN + c;
#define PREP_ROW(r) (((r) >= 0 && (r) < L) ? *(const u32x4*)(ua + (size_t)(r) * ABIN) : z)
#define PREP_ACC(S, v, sg) do { S[0] += sg bflo(v.x); S[1] += sg bfhi(v.x); S[2] += sg bflo(v.y); S[3] += sg bfhi(v.y); S[4] += sg bflo(v.z); S[5] += sg bfhi(v.z); S[6] += sg bflo(v.w); S[7] += sg bfhi(v.w); } while (0)
                              u32x4 vc[8], vin[7], vout[7];
#pragma unroll
                              for (int j = 0; j < 8; ++j) vc[j] = *(const u32x4*)(ua + (size_t)(tlA + j) * ABIN);
#pragma unroll
                              for (int j = 0; j < 7; ++j) { vin[j] = PREP_ROW(tlA + j + hw); vout[j] = PREP_ROW(tlA + j - hw); }
                              for (int q = 0; q < 2 * hw; ++q) { const u32x4 v = PREP_ROW(tlA - hw + q); PREP_ACC(S, v, +); }
#pragma unroll
                              for (int j = 0; j < 8; ++j) { const int tl = tlA + j; const int lo_ = max(tl - hw, 0), hi_ = min(tl + hw, L); const float inv = 1.0f / (float)(hi_ - lo_);
                                  const u32x4 v = vc[j];
                                  u32x4 o; o.x = pk2(S[0] * inv - bflo(v.x), S[1] * inv - bfhi(v.x)); o.y = pk2(S[2] * inv - bflo(v.y), S[3] * inv - bfhi(v.y));
                                  o.z = pk2(S[4] * inv - bflo(v.z), S[5] * inv - bfhi(v.z)); o.w = pk2(S[6] * inv - bflo(v.w), S[7] * inv - bfhi(v.w));
                                  *(u32x4*)(PB + (size_t)(s0 + tl) * 1024 + c) = o;
                                  if (j < 7) { const u32x4 va = vin[j], vs_ = vout[j]; PREP_ACC(S, va, +); PREP_ACC(S, vs_, -); } }
#undef PREP_ACC
#undef PREP_ROW
                            }
                            float x1k[8][8];
#pragma unroll
                            for (int comp = 0; comp < 3; ++comp) { const int cc = comp * 1024 + c; const bf16* ub = HB + (size_t)s0 * ABIN + 1024 + cc;
                                float w0[8], w1[8], w2[8], bb[8];
#pragma unroll
                                for (int e = 0; e < 8; e += 4) { const f32x4 a0 = *(const f32x4*)(cw + cc + e), a1 = *(const f32x4*)(cw + 3072 + cc + e), a2 = *(const f32x4*)(cw + 6144 + cc + e), a3 = *(const f32x4*)(cb + cc + e);
#pragma unroll
                                    for (int x = 0; x < 4; ++x) { w0[e + x] = a0[x]; w1[e + x] = a1[x]; w2[e + x] = a2[x]; bb[e + x] = a3[x]; } }
                                u32x4 rows[10];
#pragma unroll
                                for (int q = 0; q < 10; ++q) { const int r = tlA - 1 + q; rows[q] = (r >= 0 && r < L) ? *(const u32x4*)(ub + (size_t)r * ABIN) : z; }
#pragma unroll
                                for (int j = 0; j < 8; ++j) { float uc[8];
                                    const unsigned am[4] = {rows[j].x, rows[j].y, rows[j].z, rows[j].w}, a0[4] = {rows[j + 1].x, rows[j + 1].y, rows[j + 1].z, rows[j + 1].w}, ap[4] = {rows[j + 2].x, rows[j + 2].y, rows[j + 2].z, rows[j + 2].w};
#pragma unroll
                                    for (int e = 0; e < 8; ++e) { const float xm = (e & 1) ? bfhi(am[e >> 1]) : bflo(am[e >> 1]), x0 = (e & 1) ? bfhi(a0[e >> 1]) : bflo(a0[e >> 1]), xp = (e & 1) ? bfhi(ap[e >> 1]) : bflo(ap[e >> 1]);
                                        uc[e] = xm * w0[e] + x0 * w1[e] + xp * w2[e] + bb[e]; }
                                    const size_t orow = (size_t)(tA + j) * 1024 + c;
                                    if (comp == 0) { u32x4 o; o.x = pk2(uc[0], uc[1]); o.y = pk2(uc[2], uc[3]); o.z = pk2(uc[4], uc[5]); o.w = pk2(uc[6], uc[7]); *(u32x4*)(X0B + orow) = o; }
                                    else if (comp == 1) {
#pragma unroll
                                        for (int e = 0; e < 8; ++e) x1k[j][e] = uc[e]; }
                                    else { u32x4 o; o.x = pk2(uc[0] * x1k[j][0], uc[1] * x1k[j][1]); o.y = pk2(uc[2] * x1k[j][2], uc[3] * x1k[j][3]); o.z = pk2(uc[4] * x1k[j][4], uc[5] * x1k[j][5]); o.w = pk2(uc[6] * x1k[j][6], uc[7] * x1k[j][7]);
                                        *(u32x4*)(VVB + orow) = o; LAS unsigned* dl = vvl + (tlocA + j) * 513 + ck * 4; dl[0] = o.x; dl[1] = o.y; dl[2] = o.z; dl[3] = o.w; } } }
                          }
                          __syncthreads();
                          { int l2_ = lane; asm volatile("" : "+v"(l2_)); const LAS unsigned short* vs = (const LAS unsigned short*)vvl; const int tt = l2_ & 31, cp = l2_ >> 5;
                            for (int k = 0; k < 64; ++k) { const int c = 2 * (wave * 64 + k) + cp; VVT[(size_t)c * T + tok0 + tt] = vs[tt * 1026 + c]; } }
                          __syncthreads();
                        }
                    }
                    SEAM(ph); ++ph;
                    if (RUN(ph)) {
                        { PHASE_IDS
                        { unsigned char* mixw = ws + WS_WMIX + (size_t)ib * SZ_MIX; pg8::Gemm g{PB, (const bf16*)(mixw + SZ_ABIN + SZ_DD), T, 1024, 256, 1024, 256, 512}; pg8::StaticOrder S; S.init(T, 1024, G, (int)blockIdx.x);
                          pg8::EpiColScale E{AMIX, D, ka->in[I_POOLS] + ib * 1024};
                          pg8::gemm_phase<pg8::EpiColScale, true>(lds, g, S, E, tid); }
                        }
                        { PHASE_IDS
                        for (int it = (int)blockIdx.x; it < 512; it += G) {
                            if (it < 256) { if (it & 1) conv_item<true, 1>(ws, ka, ib, it >> 1, 0, lds, tid, lane, wave); else conv_item<true, 0>(ws, ka, ib, it >> 1, 0, lds, tid, lane, wave); }
                            else conv_item<false, 2>(ws, ka, ib, (it - 256) >> 1, (it - 256) & 1, lds, tid, lane, wave); }
                        }
                    }
                    SEAM(ph); ++ph;
                } else {
                    if (RUN(ph)) { PHASE_IDS
                        int tab_key = -1;
                        for (int u = blockIdx.x; u < 1536; u += G) att::attn_unit(HB, AMIX, ka->in[I_SINK] + ib * 16, ka->in[I_RELB], u, lds, tid, lane, wave, tab_key);
                    }
                    SEAM(ph); ++ph;
                }
                if (RUN(ph)) { PHASE_IDS
                    unsigned char* mixw = ws + WS_WMIX + (size_t)ib * SZ_MIX; pg8::Gemm g{AMIX, (const bf16*)(even ? mixw + SZ_ABIN : mixw + SZ_ABIN + SZ_DD + SZ_POOL + SZ_QKV), T, D, D, D, 64, 0, 0, 256 * 64 * 2}; pg8::StaticOrder S; S.init(T, D, G, (int)blockIdx.x, 1);
                    pg8::EpiResid E{XB, PART, 1.0f};
                    pg8::gemm_phase<pg8::EpiResid, true>(lds, g, S, E, tid);
                }
                SEAM(ph); ++ph;
            }
        }
    }
    if (RUN(ph)) { PHASE_IDS
        const float* gn = ka->in[I_NFIN];
        for (int m = gw; m < T; m += NGW) {
            float s = lane < 32 ? PART[(size_t)m * 32 + lane] : 0.f; s = wave_sum(s); const float rs = 1.0f / sqrtf(s * (1.0f / D) + EPS);
            f32x4* x4 = (f32x4*)(OUT + (size_t)m * D) + lane; const f32x4* g4 = (const f32x4*)gn + lane; const u32x2* xb2 = (const u32x2*)(XB + ((size_t)(m >> 8) * (32 * 256) + (size_t)(lane >> 4) * 256 + (m & 255)) * 64 + 4 * (lane & 15));
#pragma unroll
            for (int j = 0; j < 8; ++j) { const u32x2 xw = xb2[(size_t)j * (4 * 256 * 64 / 4)]; const f32x4 v = (f32x4){bflo(xw.x), bfhi(xw.x), bflo(xw.y), bfhi(xw.y)}, gg = g4[64 * j]; x4[64 * j] = v * rs * gg; }
        }
    }
#undef RUN
#undef SEAM
}

extern "C" void kernel_launch(void* const* d_in, const int* in_sizes, int n_in, void* d_out, int out_size, void* d_ws, size_t ws_size, hipStream_t stream) {
    static int grid = 0;
    if (grid == 0) {
        if (n_in != 30 || out_size != T * D || ws_size < WS_END) { fprintf(stderr, "kernel_launch: unexpected shapes (n_in %d, out %d, ws %zu < %zu)\n", n_in, out_size, ws_size, (size_t)WS_END); grid = -1; return; }
        int dev = 0, cus = 0, per_cu = 0;
        if (hipGetDevice(&dev) != hipSuccess || hipDeviceGetAttribute(&cus, hipDeviceAttributeMultiprocessorCount, dev) != hipSuccess) { grid = -1; return; }
        if (hipFuncSetAttribute((const void*)fwd_kernel, hipFuncAttributeMaxDynamicSharedMemorySize, LDS_BYTES) != hipSuccess) { fprintf(stderr, "kernel_launch: hipFuncSetAttribute failed\n"); grid = -1; return; }
        if (hipOccupancyMaxActiveBlocksPerMultiprocessor(&per_cu, (const void*)fwd_kernel, 512, LDS_BYTES) != hipSuccess || per_cu < 1) { fprintf(stderr, "kernel_launch: occupancy query reports %d\n", per_cu); }
        (void)hipGetLastError();
        grid = cus;
    }
    if (grid < 0) return;
    (void)hipMemsetAsync((char*)d_ws + WS_CTL, 0, CTL_BYTES, stream);
    Args a{};
    for (int i = 0; i < 30; ++i) a.in[i] = (const float*)d_in[i];
    a.out = (float*)d_out; a.ws = (unsigned char*)d_ws;
#if MK_PER_PHASE
    for (int p = 0; p < NPHASES; ++p) { a.ph_lo = p; a.ph_hi = p + 1; hipLaunchKernelGGL(fwd_kernel, dim3(grid), dim3(512), LDS_BYTES, stream, a); }
#else
    a.ph_lo = 0; a.ph_hi = NPHASES;
    hipLaunchKernelGGL(fwd_kernel, dim3(grid), dim3(512), LDS_BYTES, stream, a);
#endif
}
```
